# Optimizing an MI355X kernel written in HIP

```python
import jax, jax.numpy as jnp
from jax import lax
import numpy as np

D_MODEL = 1024
BATCH = 4
SEQ = 4096
DEPTH = 4

GRID_W = 64
CTX_LEN = 256
N_MIXERS = 3
ROPE_THETA = 10000.0
DEEPNORM_ALPHA = (2 * DEPTH) ** 0.25
DEEPNORM_BETA = (8 * DEPTH) ** -0.25
LN_EPS = 1e-5
RMS_EPS = 1e-6
ATTN_HEAD_DIM = 128
ATTN_Q_HEADS = D_MODEL // ATTN_HEAD_DIM
ATTN_KV_HEADS = 2
ATTN_GROUP = ATTN_Q_HEADS // ATTN_KV_HEADS
Q_BLOCK = 128
CMLP_CHUNK = 128
CMLP_INNER = 2 * D_MODEL
CMLP_GROUPS = 8
CMLP_GROUP_DIM = CMLP_INNER // CMLP_GROUPS
RET_HEADS = 4
RET_KEY_DIM = D_MODEL // RET_HEADS
RET_VALUE_DIM = 2 * RET_KEY_DIM
RET_CHUNK = 128
FFN_DIM = (7 * D_MODEL) // 2
MOE_EXPERTS = 8
MOE_TOP_K = 2

kernel_name = 'hybrid_diffusion_interleaved_gqa_gmlp_retention_moe'


def layer_norm(x, g, b):
    xf = x.astype(jnp.float32)
    mu = jnp.mean(xf, axis=-1, keepdims=True)
    var = jnp.mean(jnp.square(xf - mu), axis=-1, keepdims=True)
    y = (xf - mu) * lax.rsqrt(var + LN_EPS) * g.astype(jnp.float32) + b.astype(jnp.float32)
    return y.astype(x.dtype)


def rms_norm(x, g=None):
    xf = x.astype(jnp.float32)
    y = xf * lax.rsqrt(jnp.mean(jnp.square(xf), axis=-1, keepdims=True) + RMS_EPS)
    if g is not None:
        y = y * g.astype(jnp.float32)
    return y.astype(x.dtype)


def axial_rope(x, row, col):
    d = x.shape[-1]
    nf = d // 4
    inv_freq = ROPE_THETA ** (-jnp.arange(nf, dtype=jnp.float32) / nf)
    xf = x.astype(jnp.float32)

    def rotate(seg, pos):
        ang = pos.astype(jnp.float32)[:, None] * inv_freq
        cos = jnp.cos(ang)[None, :, None, :]
        sin = jnp.sin(ang)[None, :, None, :]
        a, b = seg[..., :nf], seg[..., nf:]
        return jnp.concatenate([a * cos - b * sin, b * cos + a * sin], axis=-1)

    out = jnp.concatenate([rotate(xf[..., : d // 2], row), rotate(xf[..., d // 2:], col)], axis=-1)
    return out.astype(x.dtype)


def adaln(cond, w, b):
    return jnp.split(jax.nn.silu(cond) @ w + b, 6, axis=-1)


def modulate(x, shift, scale):
    return x * (1.0 + scale) + shift


def attend(q, k, v):
    s = jnp.einsum('bqhgd,bkhd->bhgqk', q, k).astype(jnp.float32)
    p = jax.nn.softmax(s, axis=-1).astype(v.dtype)
    return jnp.einsum('bhgqk,bkhd->bqhgd', p, v)


def attention_mixer(hc, hx, row, col, wqkv, q_norm, k_norm, wo, need_ctx):
    B, S, _ = hx.shape
    C = hc.shape[1]
    nq = ATTN_Q_HEADS * ATTN_HEAD_DIM
    nkv = ATTN_KV_HEADS * ATTN_HEAD_DIM
    scale = ATTN_HEAD_DIM ** -0.5

    def project(h):
        b_, L, _ = h.shape
        t = h @ wqkv
        q = rms_norm(t[..., :nq].reshape(b_, L, ATTN_Q_HEADS, ATTN_HEAD_DIM), q_norm)
        k = rms_norm(t[..., nq:nq + nkv].reshape(b_, L, ATTN_KV_HEADS, ATTN_HEAD_DIM), k_norm)
        v = t[..., nq + nkv:].reshape(b_, L, ATTN_KV_HEADS, ATTN_HEAD_DIM)
        return q, k, v

    qc, kc, vc = project(hc)
    qx, kx, vx = project(hx)
    qx = axial_rope(qx, row, col)
    kx = axial_rope(kx, row, col)
    k_all = jnp.concatenate([kc, kx], axis=1)
    v_all = jnp.concatenate([vc, vx], axis=1)
    n_blk = S // Q_BLOCK
    q_blocks = (qx * scale).reshape(B, n_blk, Q_BLOCK, ATTN_KV_HEADS, ATTN_GROUP, ATTN_HEAD_DIM).swapaxes(0, 1)
    o_blocks = lax.map(lambda qb: attend(qb, k_all, v_all), q_blocks)
    yx = o_blocks.swapaxes(0, 1).reshape(B, S, nq) @ wo
    yc = None
    if need_ctx:
        oc = attend((qc * scale).reshape(B, C, ATTN_KV_HEADS, ATTN_GROUP, ATTN_HEAD_DIM), kc, vc)
        yc = oc.reshape(B, C, nq) @ wo
    return yc, yx


def chunk_mlp_mixer(hc, hx, w_in, b_in, v_norm_g, v_norm_b, w_s, b_s, w_out, b_out, need_ctx):
    def run(h):
        B, L, _ = h.shape
        z = jax.nn.gelu(h @ w_in + b_in)
        u, v = z[..., :CMLP_INNER], z[..., CMLP_INNER:]
        v = layer_norm(v, v_norm_g, v_norm_b)
        v = v.reshape(B, L // CMLP_CHUNK, CMLP_CHUNK, CMLP_GROUPS, CMLP_GROUP_DIM)
        v = jnp.einsum('gpq,bnqgc->bnpgc', w_s, v) + b_s.T[:, :, None]
        return (u * v.reshape(B, L, CMLP_INNER)) @ w_out + b_out

    yx = run(hx)
    yc = run(hc) if need_ctx else None
    return yc, yx


def retention_scan(q, k, v, log_gamma, state0):
    B, L, H, _ = q.shape
    n = L // RET_CHUNK

    def to_chunks(t):
        return t.reshape(B, n, RET_CHUNK, H, t.shape[-1]).transpose(1, 0, 3, 2, 4)

    idx = jnp.arange(RET_CHUNK, dtype=jnp.float32)
    diff = idx[:, None] - idx[None, :]
    inner_decay = jnp.where(diff >= 0, jnp.exp(jnp.maximum(diff, 0.0) * log_gamma[:, None, None]), 0.0)
    cross_decay = jnp.exp((idx + 1.0) * log_gamma[:, None])
    state_weight = jnp.exp((RET_CHUNK - 1.0 - idx) * log_gamma[:, None])
    chunk_decay = jnp.exp(RET_CHUNK * log_gamma)

    def step(state, qkv):
        qc, kc, vc = qkv
        scores = jnp.einsum('bhid,bhjd->bhij', qc, kc) * inner_decay
        out = (jnp.einsum('bhij,bhje->bhie', scores, vc)
               + jnp.einsum('bhid,bhde->bhie', qc, state) * cross_decay[..., None])
        state = (state * chunk_decay[:, None, None]
                 + jnp.einsum('bhjd,bhje->bhde', kc * state_weight[..., None], vc))
        return state, out

    state, out = lax.scan(step, state0, (to_chunks(q), to_chunks(k), to_chunks(v)))
    out = out.transpose(1, 0, 3, 2, 4).reshape(B, L, H, v.shape[-1])
    return out, state


def retention_mixer(hc, hx, row, col, wqkvg, decay_raw, wo, need_ctx):
    nk = RET_HEADS * RET_KEY_DIM
    nv = RET_HEADS * RET_VALUE_DIM
    log_gamma = -jnp.exp(decay_raw.astype(jnp.float32))

    def project(h, rotate):
        B, L, _ = h.shape
        t = h @ wqkvg
        q = t[..., :nk].reshape(B, L, RET_HEADS, RET_KEY_DIM)
        k = t[..., nk:2 * nk].reshape(B, L, RET_HEADS, RET_KEY_DIM) * (RET_KEY_DIM ** -0.5)
        v = t[..., 2 * nk:2 * nk + nv].reshape(B, L, RET_HEADS, RET_VALUE_DIM)
        g = t[..., 2 * nk + nv:]
        if rotate:
            q = axial_rope(q, row, col)
            k = axial_rope(k, row, col)
        return q.astype(jnp.float32), k.astype(jnp.float32), v.astype(jnp.float32), g

    def flip(t):
        return jnp.flip(t, axis=1)

    def finish(o_fwd, o_bwd_rev, g):
        o = rms_norm(o_fwd + flip(o_bwd_rev))
        B, L = o.shape[:2]
        return (jax.nn.silu(g) * o.reshape(B, L, nv).astype(g.dtype)) @ wo

    qc, kc, vc, gc = project(hc, False)
    qx, kx, vx, gx = project(hx, True)
    zero = jnp.zeros((hx.shape[0], RET_HEADS, RET_KEY_DIM, RET_VALUE_DIM), jnp.float32)
    oc_f, state_f = retention_scan(qc, kc, vc, log_gamma[0], zero)
    oc_b, state_b = retention_scan(flip(qc), flip(kc), flip(vc), log_gamma[1], zero)
    ox_f, _ = retention_scan(qx, kx, vx, log_gamma[0], state_f)
    ox_b, _ = retention_scan(flip(qx), flip(kx), flip(vx), log_gamma[1], state_b)
    yx = finish(ox_f, ox_b, gx)
    yc = finish(oc_f, oc_b, gc) if need_ctx else None
    return yc, yx


def swiglu(h, w_gu, w_down):
    g, u = jnp.split(h @ w_gu, 2, axis=-1)
    return (jax.nn.silu(g) * u) @ w_down


def moe_swiglu(h, router, w_gu, w_down):
    shp = h.shape
    t = h.reshape(-1, shp[-1])
    logits = (t @ router).astype(jnp.float32)
    top_logit, top_idx = lax.top_k(logits, MOE_TOP_K)
    top_w = jax.nn.softmax(top_logit, axis=-1)
    gates = jnp.sum(jax.nn.one_hot(top_idx, MOE_EXPERTS, dtype=jnp.float32) * top_w[..., None], axis=1)
    out = jnp.zeros_like(t)
    for e in range(MOE_EXPERTS):
        out = out + gates[:, e:e + 1].astype(t.dtype) * swiglu(t, w_gu[e], w_down[e])
    return out.reshape(shp)


def setup_inputs(seed: int = 0) -> dict:
    key = jax.random.key(seed)
    keys = iter(jax.random.split(key, 96))

    def nrm(shape, scale):
        return scale * jax.random.normal(next(keys), shape, jnp.float32)

    D = D_MODEL
    p = {}
    p['x'] = nrm((BATCH, SEQ, D), 1.0)
    p['c'] = nrm((BATCH, D), 1.0)
    p['ctx'] = nrm((BATCH, CTX_LEN, D), 1.0)
    p['c_ctx'] = nrm((D,), 1.0)
    for i in range(DEPTH):
        pre = 'l%d_' % i
        p[pre + 'ada_w'] = nrm((D, 6 * D), D ** -0.5)
        p[pre + 'ada_b'] = nrm((6 * D,), 0.02)
        p[pre + 'ln1_g'] = 1.0 + nrm((D,), 0.02)
        p[pre + 'ln1_b'] = nrm((D,), 0.02)
        p[pre + 'ln2_g'] = 1.0 + nrm((D,), 0.02)
        p[pre + 'ln2_b'] = nrm((D,), 0.02)
        kind = i % N_MIXERS
        if kind == 0:
            nq = ATTN_Q_HEADS * ATTN_HEAD_DIM
            p[pre + 'attn_wqkv'] = nrm((D, nq + 2 * ATTN_KV_HEADS * ATTN_HEAD_DIM), D ** -0.5)
            p[pre + 'attn_q_norm'] = 1.0 + nrm((ATTN_HEAD_DIM,), 0.02)
            p[pre + 'attn_k_norm'] = 1.0 + nrm((ATTN_HEAD_DIM,), 0.02)
            p[pre + 'attn_wo'] = nrm((nq, D), nq ** -0.5 * DEEPNORM_BETA)
        elif kind == 1:
            p[pre + 'cmlp_w_in'] = nrm((D, 2 * CMLP_INNER), D ** -0.5)
            p[pre + 'cmlp_b_in'] = nrm((2 * CMLP_INNER,), 0.02)
            p[pre + 'cmlp_v_norm_g'] = 1.0 + nrm((CMLP_INNER,), 0.02)
            p[pre + 'cmlp_v_norm_b'] = nrm((CMLP_INNER,), 0.02)
            p[pre + 'cmlp_w_s'] = nrm((CMLP_GROUPS, CMLP_CHUNK, CMLP_CHUNK), CMLP_CHUNK ** -0.5)
            p[pre + 'cmlp_b_s'] = 1.0 + nrm((CMLP_GROUPS, CMLP_CHUNK), 0.02)
            p[pre + 'cmlp_w_out'] = nrm((CMLP_INNER, D), CMLP_INNER ** -0.5 * DEEPNORM_BETA)
            p[pre + 'cmlp_b_out'] = nrm((D,), 0.02)
        else:
            nk = RET_HEADS * RET_KEY_DIM
            nv = RET_HEADS * RET_VALUE_DIM
            p[pre + 'ret_wqkvg'] = nrm((D, 2 * nk + 2 * nv), D ** -0.5)
            gamma = 1.0 - jnp.exp2(-5.0 - jnp.arange(RET_HEADS, dtype=jnp.float32))
            base = jnp.log(-jnp.log(gamma))
            p[pre + 'ret_decay'] = base[None, :] + nrm((2, RET_HEADS), 0.1)
            p[pre + 'ret_wo'] = nrm((nv, D), nv ** -0.5 * DEEPNORM_BETA)
        if i % 2 == 0:
            p[pre + 'ffn_w_gu'] = nrm((D, 2 * FFN_DIM), D ** -0.5)
            p[pre + 'ffn_w_down'] = nrm((FFN_DIM, D), FFN_DIM ** -0.5 * DEEPNORM_BETA)
        else:
            p[pre + 'moe_router'] = nrm((D, MOE_EXPERTS), D ** -0.5)
            p[pre + 'moe_w_gu'] = nrm((MOE_EXPERTS, D, 2 * FFN_DIM), D ** -0.5)
            p[pre + 'moe_w_down'] = nrm((MOE_EXPERTS, FFN_DIM, D), FFN_DIM ** -0.5 * DEEPNORM_BETA)
    return p


def reference(x, c, ctx, c_ctx,
              l0_ada_w, l0_ada_b, l0_ln1_g, l0_ln1_b, l0_ln2_g, l0_ln2_b,
              l0_attn_wqkv, l0_attn_q_norm, l0_attn_k_norm, l0_attn_wo,
              l0_ffn_w_gu, l0_ffn_w_down,
              l1_ada_w, l1_ada_b, l1_ln1_g, l1_ln1_b, l1_ln2_g, l1_ln2_b,
              l1_cmlp_w_in, l1_cmlp_b_in, l1_cmlp_v_norm_g, l1_cmlp_v_norm_b,
              l1_cmlp_w_s, l1_cmlp_b_s, l1_cmlp_w_out, l1_cmlp_b_out,
              l1_moe_router, l1_moe_w_gu, l1_moe_w_down,
              l2_ada_w, l2_ada_b, l2_ln1_g, l2_ln1_b, l2_ln2_g, l2_ln2_b,
              l2_ret_wqkvg, l2_ret_decay, l2_ret_wo,
              l2_ffn_w_gu, l2_ffn_w_down,
              l3_ada_w, l3_ada_b, l3_ln1_g, l3_ln1_b, l3_ln2_g, l3_ln2_b,
              l3_attn_wqkv, l3_attn_q_norm, l3_attn_k_norm, l3_attn_wo,
              l3_moe_router, l3_moe_w_gu, l3_moe_w_down):
    layers = [
        (l0_ada_w, l0_ada_b, (l0_ln1_g, l0_ln1_b), (l0_ln2_g, l0_ln2_b),
         (l0_attn_wqkv, l0_attn_q_norm, l0_attn_k_norm, l0_attn_wo),
         (l0_ffn_w_gu, l0_ffn_w_down)),
        (l1_ada_w, l1_ada_b, (l1_ln1_g, l1_ln1_b), (l1_ln2_g, l1_ln2_b),
         (l1_cmlp_w_in, l1_cmlp_b_in, l1_cmlp_v_norm_g, l1_cmlp_v_norm_b,
          l1_cmlp_w_s, l1_cmlp_b_s, l1_cmlp_w_out, l1_cmlp_b_out),
         (l1_moe_router, l1_moe_w_gu, l1_moe_w_down)),
        (l2_ada_w, l2_ada_b, (l2_ln1_g, l2_ln1_b), (l2_ln2_g, l2_ln2_b),
         (l2_ret_wqkvg, l2_ret_decay, l2_ret_wo),
         (l2_ffn_w_gu, l2_ffn_w_down)),
        (l3_ada_w, l3_ada_b, (l3_ln1_g, l3_ln1_b), (l3_ln2_g, l3_ln2_b),
         (l3_attn_wqkv, l3_attn_q_norm, l3_attn_k_norm, l3_attn_wo),
         (l3_moe_router, l3_moe_w_gu, l3_moe_w_down)),
    ]
    n_tok = x.shape[1]
    ROWS = n_tok // GRID_W
    row = jnp.repeat(jnp.arange(ROWS, dtype=jnp.int32), GRID_W)
    col = jnp.arange(ROWS * GRID_W, dtype=jnp.int32) % GRID_W
    C = ctx.shape[1]
    xc = ctx
    for i in range(DEPTH):
        ada_w, ada_b, ln1, ln2, mix_p, ffn_p = layers[i]
        need_ctx = i < DEPTH - 1
        sh1x, sc1x, g1x, sh2x, sc2x, g2x = [t[:, None, :] for t in adaln(c, ada_w, ada_b)]
        sh1c, sc1c, g1c, sh2c, sc2c, g2c = adaln(c_ctx, ada_w, ada_b)

        hx = modulate(x, sh1x, sc1x)
        hc = modulate(xc, sh1c, sc1c)
        kind = i % N_MIXERS
        if kind == 0:
            yc, yx = attention_mixer(hc, hx, row, col, *mix_p, need_ctx=need_ctx)
        elif kind == 1:
            yc, yx = chunk_mlp_mixer(hc, hx, *mix_p, need_ctx=need_ctx)
        else:
            yc, yx = retention_mixer(hc, hx, row, col, *mix_p, need_ctx=need_ctx)
        x = layer_norm(DEEPNORM_ALPHA * x + g1x * yx, *ln1)
        if need_ctx:
            xc = layer_norm(DEEPNORM_ALPHA * xc + g1c * yc, *ln1)

        channel = swiglu if i % 2 == 0 else moe_swiglu
        hx = modulate(x, sh2x, sc2x)
        if need_ctx:
            hc = modulate(xc, sh2c, sc2c)
            f = channel(jnp.concatenate([hc, hx], axis=1), *ffn_p)
            fc, fx = f[:, :C], f[:, C:]
            xc = layer_norm(DEEPNORM_ALPHA * xc + g2c * fc, *ln2)
        else:
            fx = channel(hx, *ffn_p)
        x = layer_norm(DEEPNORM_ALPHA * x + g2x * fx, *ln2)
    return x
```

```cpp
#include <hip/hip_runtime.h>
#include <hip/hip_bf16.h>
#include <cstdio>
#include <cstdint>

#ifndef SINGLE_LAUNCH
#define SINGLE_LAUNCH 0
#endif

namespace pg8 {
#define PG8_LAS __attribute__((address_space(3)))
typedef unsigned short bf16_t;
typedef short bf16x8 __attribute__((ext_vector_type(8)));
typedef float f32x4 __attribute__((ext_vector_type(4)));
typedef unsigned u32x4 __attribute__((ext_vector_type(4)));
constexpr int BM = 256, BK = 64, HALF = 128, HTB = HALF * BK * 2  , STAGE_BYTES = 8 * HTB, NXCD = 8, WGM = 8;

__host__ __device__ __forceinline__ int lds_byte(int r, int c) { const int st = (r >> 4) * 2 + (c >> 5), rr = r & 15, cc = c & 31, ob = rr * 64 + cc * 2; return st * 1024 + (ob ^ (((ob >> 9) & 1) << 5)); }
__host__ __device__ __forceinline__ void stage_rc(int b, int& R, int& C) { const int st = b / 1024, sb = b % 1024, swz = sb ^ (((sb >> 9) & 1) << 5); R = (st >> 1) * 16 + swz / 64; C = (st & 1) * 32 + (swz % 64) / 2; }
__host__ __device__ __forceinline__ int perm32(int rho) { const int n = rho >> 4, i = rho & 15; return 8 * (i >> 2) + 4 * n + (i & 3); }

struct Unit { int pm, pn; };
struct Gemm { const bf16_t* A; const bf16_t* Bt; int M, N, K; const PG8_LAS unsigned char* texp; size_t estride; };

struct StaticOrder {
    int nM, nN, nwg, G, c;
    __host__ __device__ void init(int M, int N, int G_, int c_) { nM = M / BM; nN = N / BM; nwg = nM * nN; G = G_; c = c_; }
    __host__ __device__ bool next(int i, Unit& u) const {
        const long L = (long)i * G + c; if (L >= nwg) return false;
        int wgid = (int)L; { const int q = nwg / NXCD, r = nwg % NXCD, xcd = wgid % NXCD, off = wgid / NXCD; wgid = (xcd < r ? xcd * (q + 1) : r * (q + 1) + (xcd - r) * q) + off; }
        const int nig = WGM * nN, gid = wgid / nig, fm = gid * WGM, gsz = (nM - fm) < WGM ? (nM - fm) : WGM;
        u.pm = fm + ((wgid % nig) % gsz); u.pn = (wgid % nig) / gsz; return true;
    }
    __device__ __forceinline__ void a_ready(const Unit&) const {}
    __device__ __forceinline__ void done(const Unit&) const {}
};

__device__ __forceinline__ unsigned cvt_pk_bf16(float lo, float hi) { unsigned r; asm volatile("v_cvt_pk_bf16_f32 %0, %1, %2" : "=v"(r) : "v"(lo), "v"(hi)); return r; }
__device__ __forceinline__ float gelu_tanh(float x) {
    const float u = x * (0.7978845608f + 0.0356774081f * x * x);
    const float e = __builtin_amdgcn_exp2f(-2.885390082f * u);
    return x * __builtin_amdgcn_rcpf(1.0f + e);
}
__device__ __forceinline__ float silu_f(float x) { return x * __builtin_amdgcn_rcpf(1.0f + __builtin_amdgcn_exp2f(-1.4426950409f * x)); }

struct EpiStore {
    static constexpr bool PERM = true, AFTER_DRAIN = false;
    bf16_t* O; int ldc;
    __device__ __forceinline__ void operator()(const f32x4 (&acc)[2][2][4][2], const Unit& u, int wr, int wc, int fr, int fq) const {
        const int row0 = u.pm * BM + wr * 64 + fr, col0 = u.pn * BM + wc * 32 + 8 * fq;
#pragma unroll
        for (int ai = 0; ai < 2; ++ai)
#pragma unroll
            for (int m = 0; m < 4; ++m) { bf16_t* rowp = O + (size_t)(row0 + ai * HALF + m * 16) * ldc + col0;
#pragma unroll
                for (int bj = 0; bj < 2; ++bj) { const f32x4 v0 = acc[ai][bj][m][0], v1 = acc[ai][bj][m][1];
                    u32x4 w; w.x = cvt_pk_bf16(v0[0], v0[1]); w.y = cvt_pk_bf16(v0[2], v0[3]); w.z = cvt_pk_bf16(v1[0], v1[1]); w.w = cvt_pk_bf16(v1[2], v1[3]);
                    *(u32x4*)(rowp + bj * HALF) = w; } }
    }
};

struct EpiGelu {
    static constexpr bool PERM = true, AFTER_DRAIN = false;
    bf16_t* O; int ldc; const float* bias; float* PS; int stat_pn0;
    __device__ __forceinline__ void operator()(const f32x4 (&acc)[2][2][4][2], const Unit& u, int wr, int wc, int fr, int fq) const {
        const int row0 = u.pm * BM + wr * 64 + fr, col0 = u.pn * BM + wc * 32 + 8 * fq;
        f32x4 bv[2][2];
#pragma unroll
        for (int bj = 0; bj < 2; ++bj)
#pragma unroll
            for (int n = 0; n < 2; ++n) bv[bj][n] = *(const f32x4*)(bias + col0 + bj * HALF + 4 * n);
        const bool do_stat = u.pn >= stat_pn0;
#pragma unroll
        for (int ai = 0; ai < 2; ++ai)
#pragma unroll
            for (int m = 0; m < 4; ++m) { const int row = row0 + ai * HALF + m * 16; bf16_t* rowp = O + (size_t)row * ldc + col0;
                float s = 0.f, q = 0.f;
#pragma unroll
                for (int bj = 0; bj < 2; ++bj) { f32x4 v0 = acc[ai][bj][m][0] + bv[bj][0], v1 = acc[ai][bj][m][1] + bv[bj][1];
#pragma unroll
                    for (int i = 0; i < 4; ++i) { v0[i] = gelu_tanh(v0[i]); v1[i] = gelu_tanh(v1[i]); s += v0[i] + v1[i]; q += v0[i] * v0[i] + v1[i] * v1[i]; }
                    u32x4 w; w.x = cvt_pk_bf16(v0[0], v0[1]); w.y = cvt_pk_bf16(v0[2], v0[3]); w.z = cvt_pk_bf16(v1[0], v1[1]); w.w = cvt_pk_bf16(v1[2], v1[3]);
                    *(u32x4*)(rowp + bj * HALF) = w; }
                s += __shfl_xor(s, 16); s += __shfl_xor(s, 32); q += __shfl_xor(q, 16); q += __shfl_xor(q, 32);
                if (do_stat && fq == 0) { float* p = PS + ((size_t)row * 32 + (u.pn - stat_pn0) * 4 + wc) * 2; p[0] = s; p[1] = q; } }
    }
};

struct EpiSwiglu {
    static constexpr bool PERM = true, AFTER_DRAIN = false;
    bf16_t* O; int ldc;
    __device__ __forceinline__ void operator()(const f32x4 (&acc)[2][2][4][2], const Unit& u, int wr, int wc, int fr, int fq) const {
        const int row0 = u.pm * BM + wr * 64 + fr, col0 = u.pn * HALF + wc * 32 + 8 * fq;
#pragma unroll
        for (int ai = 0; ai < 2; ++ai)
#pragma unroll
            for (int m = 0; m < 4; ++m) { bf16_t* rowp = O + (size_t)(row0 + ai * HALF + m * 16) * ldc + col0;
                float h[8];
#pragma unroll
                for (int n = 0; n < 2; ++n)
#pragma unroll
                    for (int i = 0; i < 4; ++i) h[n * 4 + i] = silu_f(acc[ai][0][m][n][i]) * acc[ai][1][m][n][i];
                u32x4 w; w.x = cvt_pk_bf16(h[0], h[1]); w.y = cvt_pk_bf16(h[2], h[3]); w.z = cvt_pk_bf16(h[4], h[5]); w.w = cvt_pk_bf16(h[6], h[7]);
                *(u32x4*)rowp = w; }
    }
};

struct EpiRes {
    static constexpr bool PERM = false, AFTER_DRAIN = false;
    float* X; const float* gate; const float* bias; float alpha;
    __device__ __forceinline__ void operator()(const f32x4 (&acc)[2][2][4][2], const Unit& u, int wr, int wc, int fr, int fq) const {
        const int within = u.pm % 17, cidx = within == 0 ? 4 : u.pm / 17;
        const int col0 = u.pn * BM + wc * 32 + 4 * fq; const float* gp = gate + (size_t)cidx * 6144;
        f32x4 gv[2][2], bv[2][2];
#pragma unroll
        for (int bj = 0; bj < 2; ++bj)
#pragma unroll
            for (int n = 0; n < 2; ++n) { gv[bj][n] = *(const f32x4*)(gp + col0 + bj * HALF + n * 16);
                bv[bj][n] = bias ? *(const f32x4*)(bias + col0 + bj * HALF + n * 16) : (f32x4){0.f, 0.f, 0.f, 0.f}; }
#pragma unroll
        for (int ai = 0; ai < 2; ++ai)
#pragma unroll
            for (int m = 0; m < 4; ++m) { float* rowp = X + (size_t)(u.pm * BM + ai * HALF + wr * 64 + m * 16 + fr) * 1024 + col0;
#pragma unroll
                for (int bj = 0; bj < 2; ++bj)
#pragma unroll
                    for (int n = 0; n < 2; ++n) { f32x4* p = (f32x4*)(rowp + bj * HALF + n * 16); const f32x4 xo = *p;
                        *p = xo * alpha + gv[bj][n] * (acc[ai][bj][m][n] + bv[bj][n]); } }
    }
};

template <class Epi, class Sched, bool ALIGN_EPI = false, bool SP2 = false>
__device__ __forceinline__ void gemm_phase(PG8_LAS unsigned char* lds, const Gemm g, const Sched& S, const Epi& E) {
    const int tid = threadIdx.x, wid = __builtin_amdgcn_readfirstlane(tid >> 6), lane = tid & 63, wr = wid >> 2, wc = wid & 3, fr = lane & 15, fq = lane >> 4;
    const int K = g.K, nt = K / BK;
    unsigned voffA[2], voffB[2];
#pragma unroll
    for (int i = 0; i < 2; ++i) { int R, C; stage_rc(tid * 16 + i * 8192, R, C); const int Rb = Epi::PERM ? ((R & ~31) + perm32(R & 31)) : R;
        voffA[i] = (unsigned)(R * K + C) * 2u; voffB[i] = (unsigned)(Rb * K + C) * 2u; }
    const size_t kstep = (size_t)(BK * 2);
    const size_t hstep = (size_t)HALF * K * 2;
    const size_t tstep = 2 * hstep;
    const unsigned ldsw = (unsigned)wid * 1024u;
    const int aoff = lds_byte(wr * 64 + fr, fq * 8), boff = lds_byte(wc * 32 + fr, fq * 8);
#define PG8_EOFF(u) (g.texp ? (size_t)g.texp[(u).pm] * g.estride : (size_t)0)
#define PG8_SA(b, h) (((b) * 2 + (h)) * HTB)
#define PG8_SB(b, h) ((4 + (b) * 2 + (h)) * HTB)
#define PG8_STAGE(bufoff, gbase, voff) do { _Pragma("unroll") for (int _i = 0; _i < 2; ++_i) \
        __builtin_amdgcn_global_load_lds((const unsigned*)((const char*)(gbase) + (voff)[_i]), (PG8_LAS unsigned*)(lds + (bufoff) + ldsw + _i * 8192), 16, 0, 0); } while (0)
#define PG8_LDA(dst, b, h) do { _Pragma("unroll") for (int m = 0; m < 4; ++m) _Pragma("unroll") for (int k = 0; k < 2; ++k) dst[m][k] = *(const PG8_LAS bf16x8*)(lds + PG8_SA(b, h) + aoff + m * 2048 + k * 1024); } while (0)
#define PG8_LDB(dst, b, h) do { _Pragma("unroll") for (int n = 0; n < 2; ++n) _Pragma("unroll") for (int k = 0; k < 2; ++k) dst[n][k] = *(const PG8_LAS bf16x8*)(lds + PG8_SB(b, h) + boff + n * 2048 + k * 1024); } while (0)
#define PG8_MMA(ai, bj, At, Bt) do { __builtin_amdgcn_s_setprio(1); _Pragma("unroll") for (int m = 0; m < 4; ++m) _Pragma("unroll") for (int n = 0; n < 2; ++n) _Pragma("unroll") for (int k = 0; k < 2; ++k) \
        acc[ai][bj][m][n] = __builtin_amdgcn_mfma_f32_16x16x32_bf16(Bt[n][k], At[m][k], acc[ai][bj][m][n], 0, 0, 0); __builtin_amdgcn_s_setprio(0); } while (0)
#define PG8_WAIT_V(n) asm volatile("s_waitcnt vmcnt(" #n ")" ::: "memory")
#define PG8_WAIT_L(n) asm volatile("s_waitcnt lgkmcnt(" #n ")" ::: "memory")
#define PG8_BAR __builtin_amdgcn_s_barrier()
#define PG8_SCHED __builtin_amdgcn_sched_barrier(0)
    Unit cur, nxt; int ui = 0;
    if (!S.next(0, cur)) return;
    f32x4 acc[2][2][4][2];
#pragma unroll
    for (int a = 0; a < 2; ++a)
#pragma unroll
        for (int b = 0; b < 2; ++b)
#pragma unroll
            for (int m = 0; m < 4; ++m)
#pragma unroll
                for (int n = 0; n < 2; ++n) acc[a][b][m][n] = (f32x4){0.f, 0.f, 0.f, 0.f};
    bf16x8 At[4][2], B0[2][2], B1[2][2];
    const char* cA = (const char*)g.A + (size_t)cur.pm * tstep; const char* cB = (const char*)g.Bt + (size_t)cur.pn * tstep + PG8_EOFF(cur);
    S.a_ready(cur);
    if constexpr (SP2) {
        PG8_STAGE(PG8_SB(0, 0), cB, voffB); PG8_STAGE(PG8_SB(0, 1), cB + hstep, voffB); PG8_STAGE(PG8_SA(0, 0), cA, voffA); PG8_STAGE(PG8_SA(0, 1), cA + hstep, voffA);
        if (wr == 1) PG8_BAR;
        PG8_WAIT_V(2); PG8_BAR;
        PG8_STAGE(PG8_SB(1, 0), cB + kstep, voffB); PG8_STAGE(PG8_SA(1, 0), cA + kstep, voffA); PG8_STAGE(PG8_SB(1, 1), cB + hstep + kstep, voffB);
        PG8_WAIT_V(6); PG8_BAR;
    } else {
        PG8_STAGE(PG8_SB(0, 0), cB, voffB); PG8_STAGE(PG8_SA(0, 0), cA, voffA); PG8_STAGE(PG8_SB(0, 1), cB + hstep, voffB); PG8_STAGE(PG8_SA(0, 1), cA + hstep, voffA);
        if (wr == 1) PG8_BAR;
        PG8_WAIT_V(4); PG8_BAR;
        PG8_STAGE(PG8_SB(1, 0), cB + kstep, voffB); PG8_STAGE(PG8_SA(1, 0), cA + kstep, voffA); PG8_STAGE(PG8_SB(1, 1), cB + hstep + kstep, voffB);
        PG8_WAIT_V(6); PG8_BAR;
    }
    for (;;) {
        const bool has_next = S.next(ui + 1, nxt);
        const char* nA = has_next ? (const char*)g.A + (size_t)nxt.pm * tstep : cA; const char* nB = has_next ? (const char*)g.Bt + (size_t)nxt.pn * tstep + PG8_EOFF(nxt) : cB;
        for (int t = 0; t < nt; t += 2) {
            const bool last = (t == nt - 2);
            const char* a1 = cA + (size_t)(t + 1) * kstep;
            const char* a2 = last ? nA : cA + (size_t)(t + 2) * kstep; const char* b2 = last ? nB : cB + (size_t)(t + 2) * kstep;
            const char* a3 = a2 + kstep; const char* b3 = b2 + kstep;
            if (last && has_next) S.a_ready(nxt);
            if constexpr (SP2) {
            PG8_LDB(B0, 0, 0); PG8_LDB(B1, 0, 1); PG8_SCHED; PG8_LDA(At, 0, 0); PG8_STAGE(PG8_SA(1, 1), a1 + hstep, voffA);
            PG8_WAIT_V(8); PG8_WAIT_L(0); PG8_BAR; PG8_MMA(0, 0, At, B0); PG8_MMA(0, 1, At, B1); PG8_BAR; PG8_SCHED;
            PG8_LDA(At, 0, 1); PG8_STAGE(PG8_SB(0, 0), b2, voffB); PG8_STAGE(PG8_SB(0, 1), b2 + hstep, voffB); PG8_STAGE(PG8_SA(0, 0), a2, voffA);
            PG8_WAIT_V(8); PG8_WAIT_L(0); PG8_BAR; PG8_MMA(1, 0, At, B0); PG8_MMA(1, 1, At, B1); PG8_BAR; PG8_SCHED;
            PG8_LDB(B0, 1, 0); PG8_LDB(B1, 1, 1); PG8_SCHED; PG8_LDA(At, 1, 0); PG8_STAGE(PG8_SA(0, 1), a2 + hstep, voffA);
            PG8_WAIT_V(8); PG8_WAIT_L(0); PG8_BAR; PG8_MMA(0, 0, At, B0); PG8_MMA(0, 1, At, B1); PG8_BAR; PG8_SCHED;
            PG8_LDA(At, 1, 1); PG8_STAGE(PG8_SB(1, 0), b3, voffB); PG8_STAGE(PG8_SB(1, 1), b3 + hstep, voffB); PG8_STAGE(PG8_SA(1, 0), a3, voffA);
            PG8_WAIT_V(8); PG8_WAIT_L(0); PG8_BAR; PG8_MMA(1, 0, At, B0); PG8_MMA(1, 1, At, B1); PG8_BAR; PG8_SCHED;
            } else {
            PG8_LDB(B0, 0, 0); PG8_SCHED; PG8_LDA(At, 0, 0); PG8_STAGE(PG8_SA(1, 1), a1 + hstep, voffA);
            PG8_WAIT_L(8); PG8_BAR; PG8_WAIT_L(0); PG8_MMA(0, 0, At, B0); PG8_BAR; PG8_SCHED;
            PG8_LDB(B1, 0, 1); PG8_STAGE(PG8_SB(0, 0), b2, voffB);
            PG8_BAR; PG8_WAIT_L(0); PG8_MMA(0, 1, At, B1); PG8_BAR;
            PG8_LDA(At, 0, 1); PG8_STAGE(PG8_SA(0, 0), a2, voffA);
            PG8_BAR; PG8_WAIT_L(0); PG8_MMA(1, 0, At, B0); PG8_BAR; PG8_SCHED;
            PG8_STAGE(PG8_SB(0, 1), b2 + hstep, voffB);
            PG8_WAIT_V(6); PG8_BAR; PG8_MMA(1, 1, At, B1); PG8_BAR;
            PG8_LDB(B0, 1, 0); PG8_SCHED; PG8_LDA(At, 1, 0); PG8_STAGE(PG8_SA(0, 1), a2 + hstep, voffA);
            PG8_WAIT_L(8); PG8_BAR; PG8_WAIT_L(0); PG8_MMA(0, 0, At, B0); PG8_BAR; PG8_SCHED;
            PG8_LDB(B1, 1, 1); PG8_STAGE(PG8_SB(1, 0), b3, voffB);
            PG8_BAR; PG8_WAIT_L(0); PG8_MMA(0, 1, At, B1); PG8_BAR;
            PG8_LDA(At, 1, 1); PG8_STAGE(PG8_SA(1, 0), a3, voffA);
            PG8_BAR; PG8_WAIT_L(0); PG8_MMA(1, 0, At, B0); PG8_BAR; PG8_SCHED;
            PG8_STAGE(PG8_SB(1, 1), b3 + hstep, voffB);
            PG8_WAIT_V(6); PG8_BAR; PG8_MMA(1, 1, At, B1); PG8_BAR;
            }
        }
        if constexpr (ALIGN_EPI) { if (wr == 0) PG8_BAR; }
        if constexpr (!Epi::AFTER_DRAIN) { E(acc, cur, wr, wc, fr, fq); S.done(cur); }
        if (!has_next) break;
#pragma unroll
        for (int a = 0; a < 2; ++a)
#pragma unroll
            for (int b = 0; b < 2; ++b)
#pragma unroll
                for (int m = 0; m < 4; ++m)
#pragma unroll
                    for (int n = 0; n < 2; ++n) acc[a][b][m][n] = (f32x4){0.f, 0.f, 0.f, 0.f};
        cur = nxt; cA = nA; cB = nB; ++ui;
        if constexpr (ALIGN_EPI) { if (wr == 1) PG8_BAR; }
    }
    PG8_WAIT_V(0);
    if constexpr (!ALIGN_EPI) { if (wr == 0) PG8_BAR; }
    PG8_BAR;
    if constexpr (Epi::AFTER_DRAIN) { E.fused(acc, cur, wr, wc, fr, fq, lds, wid, lane); S.done(cur); }
#undef PG8_SA
#undef PG8_EOFF
#undef PG8_SB
#undef PG8_STAGE
#undef PG8_LDA
#undef PG8_LDB
#undef PG8_MMA
#undef PG8_WAIT_V
#undef PG8_WAIT_L
#undef PG8_BAR
#undef PG8_SCHED
}
}
namespace att {
using bf16 = __hip_bfloat16;
constexpr int   D = 128, NW = 8, QBLK = 32, KVBLK = 64;
constexpr float SCALE = 0.088388347648318440f;
constexpr float THR = 8.f;
constexpr int SDEPTH = 2;
constexpr size_t SHM_V = KVBLK * D * 2, SHM_K = KVBLK * D * 2, SHM_ATTN = 2 * SHM_V + 2 * SHM_K + NW * 64 * 4;
using bf16x8 = __attribute__((ext_vector_type(8))) short;
using s16x4  = __attribute__((ext_vector_type(4))) short;
using f32x16 = __attribute__((ext_vector_type(16))) float;
using f32x8  = __attribute__((ext_vector_type(8))) float;
using u32x4  = __attribute__((ext_vector_type(4))) unsigned;
#define KSWZ(row, colB) ((row) * 256 + ((colB) ^ (((row) & 7) << 4)))
#define SBAR() __builtin_amdgcn_sched_barrier(0)
__device__ __forceinline__ int crow(int r, int hi) { return (r & 3) + 8 * (r >> 2) + 4 * hi; }
__device__ __forceinline__ unsigned cvtpk(float lo, float hi) {
  unsigned r; asm volatile("v_cvt_pk_bf16_f32 %0, %1, %2" : "=v"(r) : "v"(lo), "v"(hi)); return r;
}
template <typename TIn> struct Stage;
template <> struct Stage<bf16>  { using T = bf16x8;
  __device__ static __forceinline__ T ld8(const bf16* p) { return *reinterpret_cast<const bf16x8*>(p); }
  __device__ static __forceinline__ bf16x8 tobf(T x) { return x; } };
template <> struct Stage<float> { using T = f32x8;
  __device__ static __forceinline__ T ld8(const float* p) { return *reinterpret_cast<const f32x8*>(p); }
  __device__ static __forceinline__ bf16x8 tobf(T x) {
    u32x4 w = {cvtpk(x[0], x[1]), cvtpk(x[2], x[3]), cvtpk(x[4], x[5]), cvtpk(x[6], x[7])}; return *reinterpret_cast<bf16x8*>(&w); } };

__device__ __forceinline__ void partialSM(f32x16& p0, f32x16& p1, float& m_reg, float& mn, float& alpha) {
  constexpr float C = SCALE * 1.4426950408889634f;
  float pmax = p0[0]; for (int r = 1; r < 16; ++r) pmax = fmaxf(pmax, p0[r]); for (int r = 0; r < 16; ++r) pmax = fmaxf(pmax, p1[r]);
  { auto rr = __builtin_amdgcn_permlane32_swap(__float_as_uint(pmax), __float_as_uint(pmax), false, false);
    pmax = fmaxf(__uint_as_float(rr[0]), __uint_as_float(rr[1])); }
  if (__builtin_expect(__all(pmax - m_reg <= THR / SCALE), 1)) { mn = m_reg; alpha = 1.f; }
  else { mn = fmaxf(m_reg, pmax); alpha = __builtin_amdgcn_exp2f((m_reg - mn) * C); m_reg = mn; }
  float mnC = -mn * C;
  for (int r = 0; r < 16; ++r) p0[r] = fmaf(p0[r], C, mnC); for (int r = 0; r < 16; ++r) p1[r] = fmaf(p1[r], C, mnC);
  for (int r = 0; r < 16; ++r) p0[r] = __builtin_amdgcn_exp2f(p0[r]);
}
__device__ __forceinline__ void finishSM(f32x16& p0, f32x16& p1, float alpha, float& l_reg, bf16x8& pa0, bf16x8& pa1, bf16x8& pa2, bf16x8& pa3) {
  for (int r = 0; r < 16; ++r) p1[r] = __builtin_amdgcn_exp2f(p1[r]);
  float ps = 0; for (int r = 0; r < 16; ++r) ps += p0[r]; for (int r = 0; r < 16; ++r) ps += p1[r];
  { auto rr = __builtin_amdgcn_permlane32_swap(__float_as_uint(ps), __float_as_uint(ps), false, false);
    ps = __uint_as_float(rr[0]) + __uint_as_float(rr[1]); }
  l_reg = l_reg * alpha + ps;
#define PK4(P, BASE, OUT) do { unsigned a0 = cvtpk(P[BASE + 0], P[BASE + 1]), a1 = cvtpk(P[BASE + 2], P[BASE + 3]);   \
    unsigned b0 = cvtpk(P[BASE + 4], P[BASE + 5]), b1 = cvtpk(P[BASE + 6], P[BASE + 7]);                              \
    auto r0 = __builtin_amdgcn_permlane32_swap(a0, b0, false, false); auto r1 = __builtin_amdgcn_permlane32_swap(a1, b1, false, false); \
    u32x4 w = {r0[0], r1[0], r0[1], r1[1]}; OUT = *reinterpret_cast<bf16x8*>(&w); } while (0)
  PK4(p0, 0, pa0); PK4(p0, 8, pa1); PK4(p1, 0, pa2); PK4(p1, 8, pa3);
#undef PK4
}
__device__ __forceinline__ void qkt(f32x16& p0, f32x16& p1, const bf16* Ks, const bf16x8* qr, int r32, int hi) {
  p0 = f32x16{}; p1 = f32x16{};
  for (int d0 = 0; d0 < 8; ++d0) { int cb = (d0 * 16 + hi * 8) * 2;
    bf16x8 b0 = *reinterpret_cast<const bf16x8*>((const char*)Ks + KSWZ(r32, cb));
    bf16x8 b1 = *reinterpret_cast<const bf16x8*>((const char*)Ks + KSWZ(32 + r32, cb));
    p0 = __builtin_amdgcn_mfma_f32_32x32x16_bf16(b0, qr[d0], p0, 0, 0, 0);
    p1 = __builtin_amdgcn_mfma_f32_32x32x16_bf16(b1, qr[d0], p1, 0, 0, 0); }
}
__device__ __forceinline__ int v_st(int k, int c) { const int kk = (k & ~0xC) | ((k & 4) << 1) | ((k & 8) >> 1); return ((kk >> 3) * 4 + (c >> 5)) * 512 + ((kk & 7) * 32 + (c & 31)) * 2; }
__device__ __forceinline__ int v_rd_base(int lane) { return ((lane & 3) << 3) | (((lane >> 2) & 3) << 6) | (((lane >> 4) & 1) << 5) | (((lane >> 5) & 1) << 8); }
constexpr int v_rd_off(int d0, int ks, int half) { return d0 * 512 + ks * 4096 + half * 2048; }
template <int OFF> __device__ __forceinline__ s16x4 tr_read(int vb) {
  s16x4 r; asm volatile("ds_read_b64_tr_b16 %0, %1 offset:%2" : "=&v"(r) : "v"(vb), "i"(OFF) : "memory"); return r;
}
template <int D0> __device__ __forceinline__ void pv_one(f32x16& od, int vb, bf16x8 pa0, bf16x8 pa1, bf16x8 pa2, bf16x8 pa3) {
  const s16x4 l0 = tr_read<v_rd_off(D0, 0, 0)>(vb), h0 = tr_read<v_rd_off(D0, 0, 1)>(vb), l1 = tr_read<v_rd_off(D0, 1, 0)>(vb), h1 = tr_read<v_rd_off(D0, 1, 1)>(vb);
  const s16x4 l2 = tr_read<v_rd_off(D0, 2, 0)>(vb), h2 = tr_read<v_rd_off(D0, 2, 1)>(vb), l3 = tr_read<v_rd_off(D0, 3, 0)>(vb), h3 = tr_read<v_rd_off(D0, 3, 1)>(vb);
  asm volatile("s_waitcnt lgkmcnt(0)" ::: "memory"); SBAR();
#define PK(L, H) (bf16x8){L[0], L[1], L[2], L[3], H[0], H[1], H[2], H[3]}
  od = __builtin_amdgcn_mfma_f32_32x32x16_bf16(pa0, PK(l0, h0), od, 0, 0, 0);
  od = __builtin_amdgcn_mfma_f32_32x32x16_bf16(pa1, PK(l1, h1), od, 0, 0, 0);
  od = __builtin_amdgcn_mfma_f32_32x32x16_bf16(pa2, PK(l2, h2), od, 0, 0, 0);
  od = __builtin_amdgcn_mfma_f32_32x32x16_bf16(pa3, PK(l3, h3), od, 0, 0, 0);
#undef PK
}
__device__ __forceinline__ void pv_d0(f32x16* o, int vb, bf16x8 pa0, bf16x8 pa1, bf16x8 pa2, bf16x8 pa3) {
  pv_one<0>(o[0], vb, pa0, pa1, pa2, pa3); pv_one<1>(o[1], vb, pa0, pa1, pa2, pa3); pv_one<2>(o[2], vb, pa0, pa1, pa2, pa3); pv_one<3>(o[3], vb, pa0, pa1, pa2, pa3);
}

template <int LDQ, int LDK, int LDO>
__device__ __forceinline__ void attn_dense_body(const bf16* Qb, const bf16* Kh, const bf16* Vh,
                                                unsigned short* Ob, int seq, char* lds) {
  using TQ = bf16;
  using St = Stage<bf16>; using SQ = Stage<TQ>;
  const int tid = threadIdx.x, wid = tid >> 6, lane = tid & 63, r32 = lane & 31, hi = lane >> 5;
  bf16* V_lds = (bf16*)lds; bf16* K_lds = (bf16*)(lds + 2 * SHM_V);
  float* ws = (float*)(lds + 2 * SHM_V + 2 * SHM_K) + wid * 64; float* li_l = ws; float* al_l = ws + 32;
  float m_reg = -1e30f, l_reg = 0; f32x16 o[4] = {}; bf16x8 qr[8];
  const TQ* Qw = Qb + (long)(wid * QBLK + r32) * LDQ + hi * 8;
#pragma unroll
  for (int d0 = 0; d0 < 8; ++d0) qr[d0] = SQ::tobf(SQ::ld8(Qw + d0 * 16));
  const int sr = tid >> 4, sc = (tid & 15) * 8, vst0 = v_st(sr, sc), vst1 = v_st(32 + sr, sc);
  const int vb0 = (int)(uintptr_t)V_lds + v_rd_base(lane);
  struct { typename St::T vs0, vs1, ks0, ks1; } sr_[SDEPTH];
#define SLOAD(i, k0) do { sr_[i].vs0 = St::ld8(&Vh[(long)((k0) + sr) * LDK + sc]); sr_[i].vs1 = St::ld8(&Vh[(long)((k0) + 32 + sr) * LDK + sc]); \
    sr_[i].ks0 = St::ld8(&Kh[(long)((k0) + sr) * LDK + sc]); sr_[i].ks1 = St::ld8(&Kh[(long)((k0) + 32 + sr) * LDK + sc]); } while (0)
#define SWRITE(b, i) do { *(bf16x8*)((char*)V_lds + (b) * SHM_V + vst0) = St::tobf(sr_[i].vs0);          \
    *(bf16x8*)((char*)V_lds + (b) * SHM_V + vst1) = St::tobf(sr_[i].vs1); int kc = sc * 2;               \
    *(bf16x8*)((char*)K_lds + (b) * SHM_K + KSWZ(sr, kc)) = St::tobf(sr_[i].ks0);                       \
    *(bf16x8*)((char*)K_lds + (b) * SHM_K + KSWZ(32 + sr, kc)) = St::tobf(sr_[i].ks1); } while (0)
#define SWAIT() do { if constexpr (SDEPTH == 2) asm volatile("s_waitcnt vmcnt(4)" ::: "memory"); else asm volatile("s_waitcnt vmcnt(0)" ::: "memory"); } while (0)
#define RESC(a) do { if (__any((a) < 1.f)) { if (hi == 0) al_l[r32] = (a); asm volatile("s_waitcnt lgkmcnt(0)" ::: "memory"); \
    for (int d = 0; d < 4; ++d) for (int r = 0; r < 16; ++r) o[d][r] *= al_l[crow(r, hi)]; } } while (0)
  f32x16 pA0, pA1, pB0, pB1; float mnA, mnB, alA, alB; bf16x8 pa0, pa1, pa2, pa3; const int NT = seq / KVBLK;
  constexpr int SE = 0, SO = SDEPTH - 1;
  SLOAD(SE, 0); asm volatile("s_waitcnt vmcnt(0)" ::: "memory"); SWRITE(0, SE); __syncthreads();
  qkt(pA0, pA1, K_lds, qr, r32, hi); partialSM(pA0, pA1, m_reg, mnA, alA);
  SLOAD(SO, KVBLK); if constexpr (SDEPTH == 2) { if (2 < NT) SLOAD(SE, 2 * KVBLK); }
  SWAIT(); SWRITE(1, SO); __syncthreads();
  for (int j = 1; j + 1 < NT; j += 2) {
    SBAR(); qkt(pB0, pB1, (bf16*)((char*)K_lds + SHM_K), qr, r32, hi);
    finishSM(pA0, pA1, alA, l_reg, pa0, pa1, pa2, pa3); SBAR();
    SLOAD(SO, (j + SDEPTH) * KVBLK); SBAR();
    pv_d0(o, vb0, pa0, pa1, pa2, pa3); partialSM(pB0, pB1, m_reg, mnB, alB);
    __syncthreads(); SWAIT(); SWRITE(0, SE);
    RESC(alB); __syncthreads();
    SBAR(); qkt(pA0, pA1, K_lds, qr, r32, hi);
    finishSM(pB0, pB1, alB, l_reg, pa0, pa1, pa2, pa3); SBAR();
    if (SDEPTH == 1 || j + 3 < NT) SLOAD(SE, (j + 1 + SDEPTH) * KVBLK); SBAR();
    pv_d0(o, vb0 + (int)SHM_V, pa0, pa1, pa2, pa3); partialSM(pA0, pA1, m_reg, mnA, alA);
    __syncthreads(); SWAIT(); SWRITE(1, SO);
    RESC(alA); __syncthreads();
  }
  SBAR(); qkt(pB0, pB1, (bf16*)((char*)K_lds + SHM_K), qr, r32, hi);
  finishSM(pA0, pA1, alA, l_reg, pa0, pa1, pa2, pa3); SBAR();
  pv_d0(o, vb0, pa0, pa1, pa2, pa3); partialSM(pB0, pB1, m_reg, mnB, alB);
  __syncthreads(); RESC(alB);
  finishSM(pB0, pB1, alB, l_reg, pa0, pa1, pa2, pa3); SBAR();
  pv_d0(o, vb0 + (int)SHM_V, pa0, pa1, pa2, pa3);
  if (hi == 0) li_l[r32] = l_reg; asm volatile("s_waitcnt lgkmcnt(0)" ::: "memory");
  float rli[16];
#pragma unroll
  for (int r = 0; r < 16; ++r) rli[r] = __builtin_amdgcn_rcpf(li_l[crow(r, hi)]);
  unsigned short* Ow = Ob + (long)(wid * QBLK) * LDO;
#pragma unroll
  for (int r = 0; r < 16; ++r) { int orow = crow(r, hi);
    for (int d0 = 0; d0 < 4; ++d0) Ow[(long)orow * LDO + d0 * 32 + r32] = (unsigned short)(cvtpk(o[d0][r] * rli[r], 0.f) & 0xffffu); }
#undef SLOAD
#undef SWRITE
#undef SWAIT
#undef RESC
}

#undef KSWZ
#undef SBAR
}
constexpr int DM = 1024, NBATCH = 4, SEQ = 4096, CTXL = 256, TPB = CTXL + SEQ  , NT = NBATCH * TPB  ;
constexpr int NLAYER = 4, FFN = 3584, NEXP = 8;
constexpr float DN_ALPHA = 1.6817928305074290f;
constexpr float LN_EPS = 1e-5f, RMS_EPS = 1e-6f;
constexpr int MOE_MAXT = 144;
constexpr int NWAVES = 8;

constexpr size_t MiB = 1u << 20;
constexpr size_t WS_CTL = 0, CTL_ZERO_BYTES = 1 * MiB;
constexpr size_t WS_ADA = 1 * MiB;
constexpr size_t WS_TI = 2 * MiB;
constexpr size_t WS_TW = 2 * MiB + 512 * 1024;
constexpr size_t WS_POS = 3 * MiB;
constexpr size_t WS_BB = 3 * MiB + 512 * 1024;
constexpr size_t WS_PS = 4 * MiB;
constexpr size_t WS_X = 10 * MiB;
constexpr size_t WS_H = 78 * MiB;
constexpr size_t WS_W = 112 * MiB;
constexpr size_t WS_WM = 192 * MiB;
constexpr size_t WS_ACT = 360 * MiB;
constexpr size_t WS_END = 768 * MiB;
constexpr size_t W_L0_QKV = WS_W, W_L0_WO = W_L0_QKV + 3 * MiB, W_L0_GU = W_L0_WO + 2 * MiB, W_L0_DN = W_L0_GU + 14 * MiB;
constexpr size_t W_L1_IN = W_L0_DN + 7 * MiB, W_L1_OUT = W_L1_IN + 8 * MiB;
constexpr size_t W_L2_IN = W_L1_OUT + 4 * MiB, W_L2_WO = W_L2_IN + 12 * MiB, W_L2_GU = W_L2_WO + 4 * MiB, W_L2_DN = W_L2_GU + 14 * MiB;
constexpr size_t W_L3_QKV = W_L2_DN + 7 * MiB, W_L3_WO = W_L3_QKV + 3 * MiB;
static_assert(W_L3_WO + 2 * MiB <= WS_WM, "weights map");
constexpr size_t WM_GU = WS_WM, WM_DN = WS_WM + 112 * MiB;
constexpr size_t A_QKV = WS_ACT, A_O = WS_ACT + 52 * MiB;
constexpr size_t A_HID = WS_ACT;
constexpr size_t A_Z = WS_ACT, A_UV = WS_ACT + 136 * MiB;
constexpr size_t A_HP = WS_ACT, A_HM = WS_ACT + 72 * MiB, A_OM = WS_ACT + 324 * MiB;
constexpr size_t A_RQ = WS_ACT, A_OF = WS_ACT + 204 * MiB, A_OB = WS_ACT + 272 * MiB, A_FIN = WS_ACT + 340 * MiB;
static_assert(A_OM + 72 * MiB <= WS_END && A_FIN + 68 * MiB <= WS_END, "act map");
constexpr int CW_TMO = 0;
constexpr int CW_BAR = 4096;
constexpr int CW_CNT = 16384;

constexpr int LDS_BYTES = 163840;
constexpr int MISC_OFF = LDS_BYTES - 512;
constexpr int LDS_MOE_OFF = LDS_BYTES - 448;

#define GAS __attribute__((address_space(1)))
#define LAS __attribute__((address_space(3)))
typedef unsigned short bf16;
typedef unsigned v4u __attribute__((ext_vector_type(4)));
typedef unsigned v2u __attribute__((ext_vector_type(2)));
typedef float f32x4 __attribute__((ext_vector_type(4)));
typedef float f32x2 __attribute__((ext_vector_type(2)));
typedef short bf16x8 __attribute__((ext_vector_type(8)));
typedef short s16x4 __attribute__((ext_vector_type(4)));
typedef GAS unsigned gu32;
#define RLX_AGENT __ATOMIC_RELAXED, __HIP_MEMORY_SCOPE_AGENT
#define LDS_WAIT() asm volatile("s_waitcnt lgkmcnt(0)" ::: "memory")
#define VM_WAIT() asm volatile("s_waitcnt vmcnt(0)" ::: "memory")
__device__ __forceinline__ unsigned f2bf(float f) { unsigned u = __builtin_bit_cast(unsigned, f); return (u + 0x7fffu + ((u >> 16) & 1u)) >> 16; }
__device__ __forceinline__ unsigned pk2(float lo, float hi) { return f2bf(lo) | (f2bf(hi) << 16); }
__device__ __forceinline__ float bf2f(unsigned short b) { return __builtin_bit_cast(float, (unsigned)b << 16); }
__device__ __forceinline__ float bflo(unsigned w) { return __builtin_bit_cast(float, w << 16); }
__device__ __forceinline__ float bfhi(unsigned w) { return __builtin_bit_cast(float, w & 0xffff0000u); }
#define XB_TMO      128
#define XB_XCNT(j)  (256  + 64 * (j))
#define XB_XSUB(j)  (1280 + 64 * (j))
#define XB_XGEN(j)  (2304 + 64 * (j))
#define XB_TOP      3328
#define XB_TOPGEN   3392
#define XCD_BAR_WORDS 3456
#define XB_SPIN_CAP (1u << 18)

__device__ __forceinline__ unsigned xb_ld(unsigned* p)              { return __hip_atomic_load(p, __ATOMIC_RELAXED, __HIP_MEMORY_SCOPE_AGENT); }
__device__ __forceinline__ unsigned xb_add(unsigned* p, unsigned v) { return __hip_atomic_fetch_add(p, v, __ATOMIC_RELAXED, __HIP_MEMORY_SCOPE_AGENT); }
__device__ __forceinline__ unsigned xb_xcc_id() { return (unsigned)__builtin_amdgcn_s_getreg((3 << 11) | 20) & 0xFu; }
#define XB_SPIN(cond, bar) do { unsigned _sp = 0; while (cond) { __builtin_amdgcn_s_sleep(1); \
    if ((++_sp & 255u) == 0u) { if (xb_ld(&(bar)[XB_TMO])) break; if (_sp > XB_SPIN_CAP) { atomicAdd(&(bar)[XB_TMO], 1u); break; } } } } while (0)

struct XcdBarrier {
    unsigned* bar; unsigned x;
    volatile LAS unsigned* st;
};

__device__ __forceinline__ XcdBarrier xcd_barrier_post(unsigned* bar, volatile LAS unsigned* st) {
    XcdBarrier b; b.bar = bar; b.x = xb_xcc_id(); b.st = st;
    if (threadIdx.x == 0) (void)xb_add(&bar[XB_XCNT(b.x)], 1u);
    return b;
}
__device__ __forceinline__ void xcd_barrier_complete(unsigned* bar, unsigned x, unsigned& nloc, unsigned& nx) {
    const unsigned G = gridDim.x * gridDim.y * gridDim.z;
    unsigned sum, cnt, mine, sp = 0u;
    for (;;) {
        sum = 0u; cnt = 0u; mine = 0u;
#pragma unroll
        for (unsigned j = 0; j < 16; ++j) { const unsigned c = xb_ld(&bar[XB_XCNT(j)]); sum += c; cnt += (c > 0u) ? 1u : 0u; mine = (j == x) ? c : mine; }
        if (sum == G) break;
        __builtin_amdgcn_s_sleep(1);
        if ((++sp & 255u) == 0u) { if (xb_ld(&bar[XB_TMO])) break; if (sp > XB_SPIN_CAP) { atomicAdd(&bar[XB_TMO], 1u); break; } }
    }
    nloc = mine > 0u ? mine : 1u; nx = cnt > 0u ? cnt : 1u;
}

__device__ __forceinline__ void xcd_barrier(const XcdBarrier& b) {
    asm volatile("s_waitcnt vmcnt(0)" ::: "memory");
    __syncthreads();
    if (threadIdx.x == 0) {
        unsigned* bar = b.bar;
        __builtin_amdgcn_s_waitcnt(0);
        unsigned nloc = b.st[0], nx = b.st[1];
        if (nloc == 0u) { xcd_barrier_complete(bar, b.x, nloc, nx); b.st[0] = nloc; b.st[1] = nx; }
        const unsigned old = xb_add(&bar[XB_XSUB(b.x)], 1u);
        const unsigned gen = old / nloc;
        if (old + 1u == (gen + 1u) * nloc) {
            __builtin_amdgcn_fence(__ATOMIC_RELEASE, "agent");
            asm volatile("s_waitcnt vmcnt(0)" ::: "memory");
            const unsigned og = xb_add(&bar[XB_TOP], 1u);
            const unsigned tg = og / nx;
            if (og + 1u == (tg + 1u) * nx) xb_add(&bar[XB_TOPGEN], 1u);
            else XB_SPIN(xb_ld(&bar[XB_TOPGEN]) == tg, bar);
            __builtin_amdgcn_fence(__ATOMIC_ACQUIRE, "agent");
            xb_add(&bar[XB_XGEN(b.x)], 1u);
            asm volatile("s_waitcnt vmcnt(0)" ::: "memory");
        } else {
            XB_SPIN(xb_ld(&bar[XB_XGEN(b.x)]) == gen, bar);
            __builtin_amdgcn_fence(__ATOMIC_ACQUIRE, "agent");
            asm volatile("s_waitcnt vmcnt(0)" ::: "memory");
        }
    }
    __syncthreads();
}
struct Args { const float* in[57]; float* out; unsigned char* ws; int ph_lo, ph_hi; };
struct Frame {
    LAS unsigned char* lds;
    unsigned char* ws;
    gu32* ctl;
    int tid, lane, wave, vcu, G;
};
__device__ __forceinline__ float wave_sum(float v) {
#pragma unroll
    for (int o = 1; o < 64; o <<= 1) v += __shfl_xor(v, o);
    return v;
}
__device__ __forceinline__ s16x4 ds_tr(const LAS unsigned char* p) { typedef short v4i16_t __attribute__((ext_vector_type(4))); return __builtin_bit_cast(s16x4, __builtin_amdgcn_ds_read_tr16_b64_v4i16((LAS v4i16_t*)p)); }
__device__ __forceinline__ bf16x8 cat44(s16x4 a, s16x4 b) { return (bf16x8){a[0], a[1], a[2], a[3], b[0], b[1], b[2], b[3]}; }
__device__ __forceinline__ float ada_at(const Frame& F, int L, int cidx, int chunk, int col) { return ((const float*)(F.ws + WS_ADA))[((size_t)(L * 5 + cidx) * 6 + chunk) * 1024 + col]; }
__device__ __forceinline__ int row_cidx(int r) { const int b = r / TPB, w = r - b * TPB; return w < CTXL ? 4 : b; }

__device__ __forceinline__ void transpose_item(const float* W, int K, int N, bf16* WT, int drow0, LAS float* scr, int k0, int n0, int lane) {
#pragma unroll 8
    for (int i = 0; i < 32; ++i) { const int kk = 2 * i + (lane >> 5); scr[kk * 33 + (lane & 31)] = W[(size_t)(k0 + kk) * N + n0 + (lane & 31)]; }
    LDS_WAIT(); asm volatile("" ::: "memory");
    const int c = lane & 7;
#pragma unroll
    for (int j = 0; j < 4; ++j) { const int n = (lane >> 3) + 8 * j; const LAS float* s = scr + (8 * c) * 33 + n;
        v4u o; o.x = pk2(s[0 * 33], s[1 * 33]); o.y = pk2(s[2 * 33], s[3 * 33]); o.z = pk2(s[4 * 33], s[5 * 33]); o.w = pk2(s[6 * 33], s[7 * 33]);
        *(GAS v4u*)(WT + (size_t)(drow0 + n) * K + k0 + 8 * c) = o; }
    LDS_WAIT(); asm volatile("" ::: "memory");
}
__device__ __forceinline__ void convert_group(Frame& F, const float* src, bf16* dst, int K, int N, int nmat, int mode, int& it0, int gw, int NGW) {
    LAS float* scr = (LAS float*)(F.lds + F.wave * 16384);
    const int nblk = N / 32, ipm = (K / 64) * nblk, total = nmat * ipm;
    int first = (it0 <= gw) ? gw - it0 : (NGW - ((it0 - gw) % NGW)) % NGW;
    for (int l = first; l < total; l += NGW) {
        const int mat = l / ipm, r = l - mat * ipm, kb = r / nblk, nb = r - kb * nblk, n0 = 32 * nb;
        int drow0 = n0;
        if (mode) { const int half = N / 2; const int j = n0 < half ? n0 : n0 - half; drow0 = 256 * (j >> 7) + (j & 127) + (n0 < half ? 0 : 128); }
        transpose_item(src + (size_t)mat * K * N, K, N, dst + (size_t)mat * K * N, drow0, scr, 64 * kb, n0, F.lane);
    }
    it0 += total;
}
__device__ __forceinline__ void ada_phase(Frame& F, const Args& args) {
    LAS float* sc = (LAS float*)(F.lds + 65536);
    LAS float* red = (LAS float*)(F.lds + 65536 + 20480);
    for (int i = F.tid; i < 5 * 1024; i += 512) { const float v = i < 4096 ? args.in[1][i] : args.in[3][i - 4096]; sc[i] = v / (1.0f + __expf(-v)); }
    __syncthreads();
    for (int u = F.vcu; u < NLAYER * 96; u += F.G) {
        const int L = u / 96, cg = u - L * 96, col = cg * 64 + F.lane;
        const float* w = (L == 0 ? args.in[4] : L == 1 ? args.in[16] : L == 2 ? args.in[33] : args.in[44]);
        const float* bsrc = (L == 0 ? args.in[5] : L == 1 ? args.in[17] : L == 2 ? args.in[34] : args.in[45]);
        float acc[5] = {0.f, 0.f, 0.f, 0.f, 0.f};
        const int k0 = F.wave * 128;
#pragma unroll 16
        for (int k = 0; k < 128; ++k) { const float wv = w[(size_t)(k0 + k) * 6144 + col];
#pragma unroll
            for (int ci = 0; ci < 5; ++ci) acc[ci] += sc[ci * 1024 + k0 + k] * wv; }
#pragma unroll
        for (int ci = 0; ci < 5; ++ci) red[(F.wave * 5 + ci) * 64 + F.lane] = acc[ci];
        __syncthreads();
        if (F.tid < 320) { const int ci = F.tid >> 6, l = F.tid & 63; float s = 0.f;
#pragma unroll
            for (int wv = 0; wv < 8; ++wv) s += red[(wv * 5 + ci) * 64 + l];
            ((float*)(F.ws + WS_ADA))[(size_t)(L * 5 + ci) * 6144 + cg * 64 + l] = s + bsrc[cg * 64 + l]; }
        __syncthreads();
    }
}
__device__ __forceinline__ void convert_set_a(Frame& F, const Args& args) {
    const int gw = F.vcu * NWAVES + F.wave, NGW = F.G * NWAVES; int it0 = 0; unsigned char* ws = F.ws;
    convert_group(F, args.in[10], (bf16*)(ws + W_L0_QKV), 1024, 1536, 1, 0, it0, gw, NGW);
    convert_group(F, args.in[13], (bf16*)(ws + W_L0_WO), 1024, 1024, 1, 0, it0, gw, NGW);
    convert_group(F, args.in[14], (bf16*)(ws + W_L0_GU), 1024, 7168, 1, 1, it0, gw, NGW);
    convert_group(F, args.in[15], (bf16*)(ws + W_L0_DN), 3584, 1024, 1, 0, it0, gw, NGW);
    convert_group(F, args.in[22], (bf16*)(ws + W_L1_IN), 1024, 4096, 1, 0, it0, gw, NGW);
    convert_group(F, args.in[28], (bf16*)(ws + W_L1_OUT), 2048, 1024, 1, 0, it0, gw, NGW);
    convert_group(F, args.in[39], (bf16*)(ws + W_L2_IN), 1024, 6144, 1, 0, it0, gw, NGW);
    convert_group(F, args.in[41], (bf16*)(ws + W_L2_WO), 2048, 1024, 1, 0, it0, gw, NGW);
    convert_group(F, args.in[42], (bf16*)(ws + W_L2_GU), 1024, 7168, 1, 1, it0, gw, NGW);
    convert_group(F, args.in[43], (bf16*)(ws + W_L2_DN), 3584, 1024, 1, 0, it0, gw, NGW);
    convert_group(F, args.in[50], (bf16*)(ws + W_L3_QKV), 1024, 1536, 1, 0, it0, gw, NGW);
    convert_group(F, args.in[53], (bf16*)(ws + W_L3_WO), 1024, 1024, 1, 0, it0, gw, NGW);
    convert_group(F, args.in[31], (bf16*)(ws + WM_GU), 1024, 7168, 8, 1, it0, gw, NGW);
    convert_group(F, args.in[32], (bf16*)(ws + WM_DN), 3584, 1024, 8, 0, it0, gw, NGW);
}
__device__ __forceinline__ void convert_set_b(Frame& F, const Args& args) {
    const int gw = F.vcu * NWAVES + F.wave, NGW = F.G * NWAVES; int it0 = 0; unsigned char* ws = F.ws;
    convert_group(F, args.in[55], (bf16*)(ws + WM_GU), 1024, 7168, 8, 1, it0, gw, NGW);
    convert_group(F, args.in[56], (bf16*)(ws + WM_DN), 3584, 1024, 8, 0, it0, gw, NGW);
}

struct RowP { int mode, L, moe; const float* g; const float* b; const float* router; };
__device__ __forceinline__ void row_phase(Frame& F, const Args& args, const RowP P) {
    float* X = (float*)(F.ws + WS_X); bf16* H = (bf16*)(F.ws + WS_H);
    LAS unsigned* lcnt = (LAS unsigned*)(F.lds + 1024);
    const bool route = (P.mode == 1 && P.moe);
    if (route) { if (F.tid < 8) lcnt[F.tid] = 0u; __syncthreads(); }
    const int gw = F.vcu * NWAVES + F.wave, NGW = F.G * NWAVES, lane = F.lane;
    const bool last = (P.mode == 2 && P.L == NLAYER - 1);
    f32x4 gv[4], bv[4];
    if (P.mode != 0) {
#pragma unroll
        for (int j = 0; j < 4; ++j) { gv[j] = ((const f32x4*)P.g)[lane + 64 * j]; bv[j] = ((const f32x4*)P.b)[lane + 64 * j]; }
    }
    for (int r = gw; r < NT; r += NGW) {
        const int b = r / TPB, w = r - b * TPB, cidx = w < CTXL ? 4 : b;
        f32x4 v[4];
        if (P.mode == 0) {
            const float* src = w < CTXL ? args.in[2] + ((size_t)b * CTXL + w) * DM : args.in[0] + ((size_t)b * SEQ + (w - CTXL)) * DM;
#pragma unroll
            for (int j = 0; j < 4; ++j) v[j] = ((const f32x4*)src)[lane + 64 * j];
        } else {
            const f32x4* xr = (const f32x4*)(X + (size_t)r * DM);
#pragma unroll
            for (int j = 0; j < 4; ++j) v[j] = xr[lane + 64 * j];
            if (P.mode == 2 && P.moe) {
                const int* pos = (const int*)(F.ws + WS_POS) + 2 * r; const float* tw = (const float*)(F.ws + WS_TW) + 2 * r;
                const int p1 = pos[0], p2 = pos[1]; const float w1 = tw[0], w2 = tw[1];
                const bf16* OM = (const bf16*)(F.ws + A_OM);
                const v2u* o1 = (const v2u*)(OM + (size_t)p1 * DM); const v2u* o2 = (const v2u*)(OM + (size_t)p2 * DM);
                const f32x4* g2 = (const f32x4*)((const float*)(F.ws + WS_ADA) + ((size_t)(P.L * 5 + cidx) * 6 + 5) * 1024);
#pragma unroll
                for (int j = 0; j < 4; ++j) { const v2u a = o1[lane + 64 * j], c = o2[lane + 64 * j]; const f32x4 gg = g2[lane + 64 * j];
                    f32x4 f; f[0] = w1 * bflo(a.x) + w2 * bflo(c.x); f[1] = w1 * bfhi(a.x) + w2 * bfhi(c.x); f[2] = w1 * bflo(a.y) + w2 * bflo(c.y); f[3] = w1 * bfhi(a.y) + w2 * bfhi(c.y);
                    v[j] = v[j] * DN_ALPHA + gg * f; }
            }
            float s = 0.f;
#pragma unroll
            for (int j = 0; j < 4; ++j) s += (v[j][0] + v[j][1]) + (v[j][2] + v[j][3]);
            const float mean = wave_sum(s) * (1.f / DM); float s2 = 0.f;
#pragma unroll
            for (int j = 0; j < 4; ++j) { v[j] = v[j] - mean; s2 += (v[j][0] * v[j][0] + v[j][1] * v[j][1]) + (v[j][2] * v[j][2] + v[j][3] * v[j][3]); }
            const float rstd = 1.f / sqrtf(wave_sum(s2) * (1.f / DM) + LN_EPS);
#pragma unroll
            for (int j = 0; j < 4; ++j) v[j] = v[j] * rstd * gv[j] + bv[j];
        }
        if (last) {
            if (w >= CTXL) { f32x4* o = (f32x4*)(args.out + ((size_t)b * SEQ + (w - CTXL)) * DM);
#pragma unroll
                for (int j = 0; j < 4; ++j) o[lane + 64 * j] = v[j]; }
            continue;
        }
        { f32x4* xo = (f32x4*)(X + (size_t)r * DM);
#pragma unroll
          for (int j = 0; j < 4; ++j) xo[lane + 64 * j] = v[j]; }
        const int ML = P.mode == 1 ? P.L : (P.mode == 0 ? 0 : P.L + 1), ch = P.mode == 1 ? 3 : 0;
        const f32x4* sh = (const f32x4*)((const float*)(F.ws + WS_ADA) + ((size_t)(ML * 5 + cidx) * 6 + ch) * 1024);
        const f32x4* scl = sh + 256;
        f32x4 h[4];
#pragma unroll
        for (int j = 0; j < 4; ++j) h[j] = v[j] * (scl[lane + 64 * j] + 1.0f) + sh[lane + 64 * j];
        { v2u* ho = (v2u*)(H + (size_t)r * DM);
#pragma unroll
          for (int j = 0; j < 4; ++j) { v2u o; o.x = pk2(h[j][0], h[j][1]); o.y = pk2(h[j][2], h[j][3]); ho[lane + 64 * j] = o; } }
        if (route) {
            float lg[8] = {0.f, 0.f, 0.f, 0.f, 0.f, 0.f, 0.f, 0.f};
#pragma unroll
            for (int j = 0; j < 4; ++j)
#pragma unroll
                for (int i = 0; i < 4; ++i) { const f32x4* rw = (const f32x4*)(P.router + (size_t)(4 * lane + 256 * j + i) * 8); const f32x4 r0 = rw[0], r1 = rw[1]; const float hv = h[j][i];
                    lg[0] += hv * r0[0]; lg[1] += hv * r0[1]; lg[2] += hv * r0[2]; lg[3] += hv * r0[3]; lg[4] += hv * r1[0]; lg[5] += hv * r1[1]; lg[6] += hv * r1[2]; lg[7] += hv * r1[3]; }
#pragma unroll
            for (int e = 0; e < 8; ++e) lg[e] = wave_sum(lg[e]);
            int e1 = 0; float l1 = lg[0];
#pragma unroll
            for (int e = 1; e < 8; ++e) if (lg[e] > l1) { l1 = lg[e]; e1 = e; }
            int e2 = -1; float l2 = -3.0e38f;
#pragma unroll
            for (int e = 0; e < 8; ++e) if (e != e1 && lg[e] > l2) { l2 = lg[e]; e2 = e; }
            if (e2 < 0) e2 = (e1 + 1) & 7;
            if (lane == 0) {
                const float w2 = 1.0f / (1.0f + __expf(l1 - l2)), w1 = 1.0f - w2;
                const unsigned lr1 = __hip_atomic_fetch_add(&lcnt[e1], 1u, __ATOMIC_RELAXED, __HIP_MEMORY_SCOPE_WORKGROUP), lr2 = __hip_atomic_fetch_add(&lcnt[e2], 1u, __ATOMIC_RELAXED, __HIP_MEMORY_SCOPE_WORKGROUP);
                v4u ti; ti.x = (unsigned)e1 | ((unsigned)e2 << 8) | ((unsigned)blockIdx.x << 16); ti.y = lr1; ti.z = lr2; ti.w = 0u;
                ((v4u*)(F.ws + WS_TI))[r] = ti; ((f32x2*)(F.ws + WS_TW))[r] = (f32x2){w1, w2};
            }
        }
    }
    if (route) {
        __syncthreads();
        if (F.tid < 8) { const unsigned base = __hip_atomic_fetch_add(F.ctl + CW_CNT + 64 * P.L + F.tid, lcnt[F.tid], RLX_AGENT);
            ((unsigned*)(F.ws + WS_BB))[blockIdx.x * 8 + F.tid] = base; }
    }
}

__device__ __forceinline__ void moe_layout(Frame& F, int L) {
    LAS unsigned* T = (LAS unsigned*)(F.lds + LDS_MOE_OFF);
    __syncthreads();
    if (F.tid == 0) {
        unsigned o = 0; LAS unsigned char* texp = (LAS unsigned char*)(T + 20);
        for (int e = 0; e < 8; ++e) { const unsigned c = __hip_atomic_load(F.ctl + CW_CNT + 64 * L + e, RLX_AGENT); const unsigned nt = (c + 255u) >> 8;
            T[1 + e] = o * 256u; T[9 + e] = c; for (unsigned t = 0; t < nt && o + t < (unsigned)MOE_MAXT; ++t) texp[o + t] = (unsigned char)e; o += nt; }
        T[0] = o < (unsigned)MOE_MAXT ? o : (unsigned)MOE_MAXT;
    }
    __syncthreads();
}
__device__ __forceinline__ void moe_scatter(Frame& F, int L) {
    moe_layout(F, L);
    const LAS unsigned* T = (const LAS unsigned*)(F.lds + LDS_MOE_OFF);
    const int gw = F.vcu * NWAVES + F.wave, NGW = F.G * NWAVES, lane = F.lane;
    const bf16* H = (const bf16*)(F.ws + WS_H); bf16* HP = (bf16*)(F.ws + A_HP);
    for (int r = gw; r < NT; r += NGW) {
        const v4u ti = ((const v4u*)(F.ws + WS_TI))[r];
        const int e1 = ti.x & 0xff, e2 = (ti.x >> 8) & 0xff, blk = ti.x >> 16;
        const unsigned* bb = (const unsigned*)(F.ws + WS_BB) + blk * 8;
        const int p1 = (int)(T[1 + e1] + bb[e1] + ti.y), p2 = (int)(T[1 + e2] + bb[e2] + ti.z);
        const v4u* src = (const v4u*)(H + (size_t)r * DM);
        const v4u a = src[lane], c = src[lane + 64];
        v4u* d1 = (v4u*)(HP + (size_t)p1 * DM); v4u* d2 = (v4u*)(HP + (size_t)p2 * DM);
        d1[lane] = a; d1[lane + 64] = c; d2[lane] = a; d2[lane + 64] = c;
        if (lane == 0) { int* pos = (int*)(F.ws + WS_POS) + 2 * r; pos[0] = p1; pos[1] = p2; }
    }
    for (int e = 0; e < 8; ++e) {
        const unsigned c = T[9 + e], o = T[1 + e], end = o + ((c + 255u) & ~255u);
        for (unsigned p = o + c + gw; p < end; p += NGW) { v4u* d = (v4u*)(HP + (size_t)p * DM); const v4u z = {0u, 0u, 0u, 0u}; d[lane] = z; d[lane + 64] = z; }
    }
}
__device__ __forceinline__ void rope_table(Frame& F, LAS f32x2* tab, int nf) {
    for (int i = F.tid; i < 64 * nf; i += 512) { const int pos = i / nf, k = i - pos * nf;
        const float inv = __builtin_amdgcn_exp2f(-(float)k / (float)nf * 13.287712379549449f);
        const float ang = (float)pos * inv, rev = ang * 0.15915494309189535f, fr = rev - floorf(rev);
        tab[i] = (f32x2){__builtin_amdgcn_cosf(fr), __builtin_amdgcn_sinf(fr)}; }
    __syncthreads();
}
__device__ __forceinline__ void attn_normrope(Frame& F, const float* qn, const float* kn) {
    LAS f32x2* tab = (LAS f32x2*)F.lds; rope_table(F, tab, 32);
    bf16* QKV = (bf16*)(F.ws + A_QKV);
    const int gw = F.vcu * NWAVES + F.wave, NGW = F.G * NWAVES, lane = F.lane;
    const int half = lane >> 5, li = lane & 31, d0 = half * 64 + li;
    const float gq0 = qn[d0], gq1 = qn[d0 + 32], gk0 = kn[d0], gk1 = kn[d0 + 32];
    for (int it = gw; it < NT * 10; it += NGW) {
        const int r = it / 10, hs = it - r * 10;
        const int b = r / TPB, w = r - b * TPB;
        bf16* p = QKV + (size_t)r * 1536 + hs * 128 + d0;
        const float a = bf2f(p[0]), c = bf2f(p[32]);
        const float ss = wave_sum(a * a + c * c);
        const float rinv = 1.0f / sqrtf(ss * (1.0f / 128.0f) + RMS_EPS);
        float xa = a * rinv * (hs < 8 ? gq0 : gk0), xb = c * rinv * (hs < 8 ? gq1 : gk1);
        if (w >= CTXL) { const int t = w - CTXL, pos = half ? (t & 63) : (t >> 6); const f32x2 cs = tab[pos * 32 + li];
            const float ra = xa * cs.x - xb * cs.y, rb = xb * cs.x + xa * cs.y; xa = ra; xb = rb; }
        p[0] = (bf16)f2bf(xa); p[32] = (bf16)f2bf(xb);
    }
}
__device__ __forceinline__ void attn_units(Frame& F, char* lds_generic) {
    const att::bf16* QKV = (const att::bf16*)(F.ws + A_QKV); unsigned short* O = (unsigned short*)(F.ws + A_O);
    for (int L = F.vcu; L < 544; L += F.G) {
        if (L < 512) { const int qb = L & 15, g = (L >> 4) & 3, kvh = (L >> 6) & 1, b = L >> 7, h = kvh * 4 + g;
            const size_t rowq = (size_t)b * TPB + CTXL + qb * 256, rowk = (size_t)b * TPB;
            att::attn_dense_body<1536, 1536, 1024>(QKV + rowq * 1536 + h * 128, QKV + rowk * 1536 + 1024 + kvh * 128, QKV + rowk * 1536 + 1280 + kvh * 128, O + rowq * 1024 + h * 128, TPB, lds_generic);
        } else { const int u = L - 512, h = u & 7, b = u >> 3, kvh = h >> 2; const size_t rowk = (size_t)b * TPB;
            att::attn_dense_body<1536, 1536, 1024>(QKV + rowk * 1536 + h * 128, QKV + rowk * 1536 + 1024 + kvh * 128, QKV + rowk * 1536 + 1280 + kvh * 128, O + rowk * 1024 + h * 128, CTXL, lds_generic);
        }
        __syncthreads();
    }
}

__device__ __forceinline__ void cmlp_mix(Frame& F, const float* vng, const float* vnb, const float* w_s, const float* b_s) {
    constexpr int WP = 272, VP = 272;
    LAS unsigned char* WS_ = F.lds;
    LAS unsigned char* VT = F.lds + 128 * WP;
    LAS f32x2* MR = (LAS f32x2*)(F.lds + 128 * WP + 256 * VP);
    const bf16* Z = (const bf16*)(F.ws + A_Z); bf16* UV = (bf16*)(F.ws + A_UV);
    const int tid = F.tid, lane = F.lane, w = F.wave, fr = lane & 15, fq = lane >> 4;
    for (int u = F.vcu; u < 136 * 8; u += F.G) {
        const int n = u >> 3, g = u & 7, row0 = n * 128;
        if (tid < 128) { const f32x2* ps = (const f32x2*)(F.ws + WS_PS) + (size_t)(row0 + tid) * 32; float s = 0.f, q = 0.f;
#pragma unroll 8
            for (int i = 0; i < 32; ++i) { const f32x2 t = ps[i]; s += t.x; q += t.y; }
            const float mean = s * (1.0f / 2048.0f), var = q * (1.0f / 2048.0f) - mean * mean;
            MR[tid] = (f32x2){mean, 1.0f / sqrtf(fmaxf(var, 0.f) + LN_EPS)}; }
#pragma unroll
        for (int i = 0; i < 8; ++i) { const int id = tid + 512 * i, p = id >> 5, q4 = (id & 31) * 4;
            const f32x4 wv = *(const f32x4*)(w_s + ((size_t)g * 128 + p) * 128 + q4);
            v2u o; o.x = pk2(wv[0], wv[1]); o.y = pk2(wv[2], wv[3]); *(LAS v2u*)(WS_ + p * WP + q4 * 2) = o; }
        __syncthreads();
        { const int ch = tid & 31, c0 = ch * 8; f32x4 ga0 = *(const f32x4*)(vng + g * 256 + c0), ga1 = *(const f32x4*)(vng + g * 256 + c0 + 4), be0 = *(const f32x4*)(vnb + g * 256 + c0), be1 = *(const f32x4*)(vnb + g * 256 + c0 + 4);
#pragma unroll
          for (int i = 0; i < 8; ++i) { const int q = (tid >> 5) + 16 * i;
              const v4u zv = *(const v4u*)(Z + (size_t)(row0 + q) * 4096 + 2048 + g * 256 + c0); const f32x2 mr = MR[q];
              float x[8] = {bflo(zv.x), bfhi(zv.x), bflo(zv.y), bfhi(zv.y), bflo(zv.z), bfhi(zv.z), bflo(zv.w), bfhi(zv.w)};
#pragma unroll
              for (int k = 0; k < 8; ++k) { const float gk = k < 4 ? ga0[k & 3] : ga1[k & 3], bk = k < 4 ? be0[k & 3] : be1[k & 3];
                  *(LAS unsigned short*)(VT + (c0 + k) * VP + q * 2) = (unsigned short)f2bf((x[k] - mr.x) * mr.y * gk + bk); } } }
        __syncthreads();
        pg8::f32x4 acc[8][2];
#pragma unroll
        for (int m = 0; m < 8; ++m) { acc[m][0] = (pg8::f32x4){0.f, 0.f, 0.f, 0.f}; acc[m][1] = (pg8::f32x4){0.f, 0.f, 0.f, 0.f}; }
#pragma unroll
        for (int ks = 0; ks < 4; ++ks) {
            const bf16x8 b0 = *(const LAS bf16x8*)(VT + (32 * w + fr) * VP + (32 * ks + 8 * fq) * 2), b1 = *(const LAS bf16x8*)(VT + (32 * w + 16 + fr) * VP + (32 * ks + 8 * fq) * 2);
#pragma unroll
            for (int m = 0; m < 8; ++m) { const bf16x8 a = *(const LAS bf16x8*)(WS_ + (16 * m + fr) * WP + (32 * ks + 8 * fq) * 2);
                acc[m][0] = __builtin_amdgcn_mfma_f32_16x16x32_bf16(a, b0, acc[m][0], 0, 0, 0); acc[m][1] = __builtin_amdgcn_mfma_f32_16x16x32_bf16(a, b1, acc[m][1], 0, 0, 0); }
        }
#pragma unroll
        for (int m = 0; m < 8; ++m)
#pragma unroll
            for (int j = 0; j < 4; ++j) { const int p = 16 * m + 4 * fq + j; const float bs = b_s[g * 128 + p];
#pragma unroll
                for (int nn = 0; nn < 2; ++nn) { const int c = 32 * w + 16 * nn + fr; const size_t zr = (size_t)(row0 + p);
                    const float uu = bf2f(Z[zr * 4096 + g * 256 + c]);
                    UV[zr * 2048 + g * 256 + c] = (bf16)f2bf(uu * (acc[m][nn][j] + bs)); } }
        __syncthreads();
    }
}

__device__ __forceinline__ void ret_rope(Frame& F) {
    LAS f32x2* tab = (LAS f32x2*)F.lds; rope_table(F, tab, 64);
    bf16* RQ = (bf16*)(F.ws + A_RQ);
    const int gw = F.vcu * NWAVES + F.wave, NGW = F.G * NWAVES, lane = F.lane;
    for (int it = gw; it < NT * 8; it += NGW) {
        const int r = it >> 3, hs = it & 7, isk = hs >> 2, h = hs & 3;
        const int b = r / TPB, w = r - b * TPB;
        if (w < CTXL && !isk) continue;
        bf16* p = RQ + (size_t)r * 6144 + isk * 1024 + h * 256;
        float a0 = bf2f(p[lane]), b0 = bf2f(p[lane + 64]), a1 = bf2f(p[128 + lane]), b1 = bf2f(p[192 + lane]);
        if (w >= CTXL) { const int t = w - CTXL; const f32x2 c0 = tab[(t >> 6) * 64 + lane], c1 = tab[(t & 63) * 64 + lane];
            const float ra0 = a0 * c0.x - b0 * c0.y, rb0 = b0 * c0.x + a0 * c0.y, ra1 = a1 * c1.x - b1 * c1.y, rb1 = b1 * c1.x + a1 * c1.y; a0 = ra0; b0 = rb0; a1 = ra1; b1 = rb1; }
        const float sc = isk ? 0.0625f : 1.0f;
        p[lane] = (bf16)f2bf(a0 * sc); p[lane + 64] = (bf16)f2bf(b0 * sc); p[128 + lane] = (bf16)f2bf(a1 * sc); p[192 + lane] = (bf16)f2bf(b1 * sc);
    }
}
__device__ __forceinline__ void ret_scan(Frame& F, const float* decay_raw) {
    constexpr int KWP = 528, VVP = 144, STP = 528, PPP = 272;
    constexpr int KW_OFF = 0, VV_OFF = 128 * KWP, ST_OFF = VV_OFF + 128 * VVP, PP_OFF = ST_OFF + 64 * STP;
    static_assert(PP_OFF + 8 * 16 * PPP <= MISC_OFF, "scan LDS map");
    LAS unsigned char* lds = F.lds;
    const bf16* RQ = (const bf16*)(F.ws + A_RQ);
    const int tid = F.tid, lane = F.lane, w = F.wave, fr = lane & 15, fq = lane >> 4, tq = (lane & 15) >> 2, tp = lane & 3;
    for (int c = F.vcu; c < 256; c += F.G) {
        const int dvs = c & 7, dir = (c >> 3) & 1, h = (c >> 4) & 3, b = c >> 6;
        bf16* OUT = (bf16*)(F.ws + (dir ? A_OB : A_OF));
        const float lg2 = -__expf(decay_raw[dir * 4 + h]) * 1.4426950408889634f;
        float sci[4], cri[4];
#pragma unroll
        for (int j = 0; j < 4; ++j) { const int i = 16 * w + 4 * fq + j;
            sci[j] = __builtin_amdgcn_exp2f((dir ? -(float)i : (float)(i - 127)) * lg2);
            cri[j] = __builtin_amdgcn_exp2f((dir ? (float)(128 - i) : (float)(i + 1)) * lg2); }
        const float cd = __builtin_amdgcn_exp2f(128.0f * lg2);
        pg8::f32x4 ST[2][4];
#pragma unroll
        for (int m = 0; m < 2; ++m)
#pragma unroll
            for (int cc = 0; cc < 4; ++cc) ST[m][cc] = (pg8::f32x4){0.f, 0.f, 0.f, 0.f};
        for (int i = tid; i < 64 * STP / 16; i += 512) *(LAS v4u*)(lds + ST_OFF + i * 16) = (v4u){0u, 0u, 0u, 0u};
        __syncthreads();
        for (int s = 0; s < 34; ++s) {
            const int chunk = dir ? (s == 0 ? 1 : (s == 1 ? 0 : 35 - s)) : s;
            const size_t row0 = (size_t)b * TPB + (size_t)chunk * 128;
#pragma unroll
            for (int i = 0; i < 8; ++i) { const int j = (tid >> 5) + 16 * i, ch = tid & 31;
                const v4u kv = *(const v4u*)(RQ + (row0 + j) * 6144 + 1024 + h * 256 + ch * 8);
                const float wj = __builtin_amdgcn_exp2f((dir ? (float)j : (float)(127 - j)) * lg2);
                v4u o; o.x = pk2(bflo(kv.x) * wj, bfhi(kv.x) * wj); o.y = pk2(bflo(kv.y) * wj, bfhi(kv.y) * wj); o.z = pk2(bflo(kv.z) * wj, bfhi(kv.z) * wj); o.w = pk2(bflo(kv.w) * wj, bfhi(kv.w) * wj);
                *(LAS v4u*)(lds + KW_OFF + j * KWP + ch * 16) = o; }
#pragma unroll
            for (int i = 0; i < 2; ++i) { const int j = (tid >> 3) + 64 * i, ch = tid & 7;
                *(LAS v4u*)(lds + VV_OFF + j * VVP + ch * 16) = *(const v4u*)(RQ + (row0 + j) * 6144 + 2048 + h * 512 + dvs * 64 + ch * 8); }
            bf16x8 qf[8];
#pragma unroll
            for (int ks = 0; ks < 8; ++ks) qf[ks] = *(const bf16x8*)(RQ + (row0 + 16 * w + fr) * 6144 + h * 256 + 32 * ks + 8 * fq);
            __syncthreads();
            LAS unsigned char* PP = lds + PP_OFF + w * 16 * PPP;
#pragma unroll
            for (int n = 0; n < 8; ++n) { pg8::f32x4 S = (pg8::f32x4){0.f, 0.f, 0.f, 0.f};
#pragma unroll
                for (int ks = 0; ks < 8; ++ks) { const bf16x8 kf = *(const LAS bf16x8*)(lds + KW_OFF + (16 * n + fr) * KWP + (32 * ks + 8 * fq) * 2);
                    S = __builtin_amdgcn_mfma_f32_16x16x32_bf16(qf[ks], kf, S, 0, 0, 0); }
                const int jj = 16 * n + fr;
#pragma unroll
                for (int j = 0; j < 4; ++j) { const int i = 16 * w + 4 * fq + j; const bool keep = dir ? (jj >= i) : (jj <= i);
                    *(LAS unsigned short*)(PP + (4 * fq + j) * PPP + jj * 2) = (unsigned short)f2bf(keep ? S[j] * sci[j] : 0.f); } }
            LDS_WAIT(); asm volatile("" ::: "memory");
            pg8::f32x4 O1[4], O2[4];
#pragma unroll
            for (int cc = 0; cc < 4; ++cc) { O1[cc] = (pg8::f32x4){0.f, 0.f, 0.f, 0.f}; O2[cc] = (pg8::f32x4){0.f, 0.f, 0.f, 0.f}; }
#pragma unroll
            for (int ks = 0; ks < 4; ++ks) { const bf16x8 pa = *(const LAS bf16x8*)(PP + fr * PPP + (32 * ks + 8 * fq) * 2);
#pragma unroll
                for (int cc = 0; cc < 4; ++cc) { const LAS unsigned char* vp = lds + VV_OFF + (32 * ks + 8 * fq + tq) * VVP + (16 * cc + 4 * tp) * 2;
                    const bf16x8 vb = cat44(ds_tr(vp), ds_tr(vp + 4 * VVP));
                    O1[cc] = __builtin_amdgcn_mfma_f32_16x16x32_bf16(pa, vb, O1[cc], 0, 0, 0); } }
#pragma unroll
            for (int ks = 0; ks < 8; ++ks)
#pragma unroll
                for (int cc = 0; cc < 4; ++cc) { const bf16x8 sb = *(const LAS bf16x8*)(lds + ST_OFF + (16 * cc + fr) * STP + (32 * ks + 8 * fq) * 2);
                    O2[cc] = __builtin_amdgcn_mfma_f32_16x16x32_bf16(qf[ks], sb, O2[cc], 0, 0, 0); }
#pragma unroll
            for (int cc = 0; cc < 4; ++cc)
#pragma unroll
                for (int j = 0; j < 4; ++j) OUT[(row0 + 16 * w + 4 * fq + j) * 2048 + h * 512 + dvs * 64 + 16 * cc + fr] = (bf16)f2bf(O1[cc][j] + cri[j] * O2[cc][j]);
            __syncthreads();
#pragma unroll
            for (int m = 0; m < 2; ++m)
#pragma unroll
                for (int cc = 0; cc < 4; ++cc) ST[m][cc] = ST[m][cc] * cd;
#pragma unroll
            for (int ks = 0; ks < 4; ++ks) { bf16x8 af[2], vb[4];
#pragma unroll
                for (int m = 0; m < 2; ++m) { const LAS unsigned char* kp = lds + KW_OFF + (32 * ks + 8 * fq + tq) * KWP + (32 * w + 16 * m + 4 * tp) * 2; af[m] = cat44(ds_tr(kp), ds_tr(kp + 4 * KWP)); }
#pragma unroll
                for (int cc = 0; cc < 4; ++cc) { const LAS unsigned char* vp = lds + VV_OFF + (32 * ks + 8 * fq + tq) * VVP + (16 * cc + 4 * tp) * 2; vb[cc] = cat44(ds_tr(vp), ds_tr(vp + 4 * VVP)); }
#pragma unroll
                for (int m = 0; m < 2; ++m)
#pragma unroll
                    for (int cc = 0; cc < 4; ++cc) ST[m][cc] = __builtin_amdgcn_mfma_f32_16x16x32_bf16(af[m], vb[cc], ST[m][cc], 0, 0, 0); }
#pragma unroll
            for (int m = 0; m < 2; ++m)
#pragma unroll
                for (int cc = 0; cc < 4; ++cc) { v2u o; o.x = pk2(ST[m][cc][0], ST[m][cc][1]); o.y = pk2(ST[m][cc][2], ST[m][cc][3]);
                    *(LAS v2u*)(lds + ST_OFF + (16 * cc + fr) * STP + (32 * w + 16 * m + 4 * fq) * 2) = o; }
            __syncthreads();
        }
    }
}
__device__ __forceinline__ void ret_finish(Frame& F) {
    const bf16* RQ = (const bf16*)(F.ws + A_RQ); const bf16* OFp = (const bf16*)(F.ws + A_OF); const bf16* OBp = (const bf16*)(F.ws + A_OB); bf16* FIN = (bf16*)(F.ws + A_FIN);
    const int gw = F.vcu * NWAVES + F.wave, NGW = F.G * NWAVES, lane = F.lane;
    for (int it = gw; it < NT * 4; it += NGW) {
        const int r = it >> 2, h = it & 3; const size_t o = (size_t)r * 2048 + h * 512 + lane * 8;
        const v4u a = *(const v4u*)(OFp + o), c = *(const v4u*)(OBp + o), gg = *(const v4u*)(RQ + (size_t)r * 6144 + 4096 + h * 512 + lane * 8);
        float x[8] = {bflo(a.x) + bflo(c.x), bfhi(a.x) + bfhi(c.x), bflo(a.y) + bflo(c.y), bfhi(a.y) + bfhi(c.y), bflo(a.z) + bflo(c.z), bfhi(a.z) + bfhi(c.z), bflo(a.w) + bflo(c.w), bfhi(a.w) + bfhi(c.w)};
        float ss = 0.f;
#pragma unroll
        for (int k = 0; k < 8; ++k) ss += x[k] * x[k];
        const float rinv = 1.0f / sqrtf(wave_sum(ss) * (1.0f / 512.0f) + RMS_EPS);
        const float gf[8] = {bflo(gg.x), bfhi(gg.x), bflo(gg.y), bfhi(gg.y), bflo(gg.z), bfhi(gg.z), bflo(gg.w), bfhi(gg.w)};
        float y[8];
#pragma unroll
        for (int k = 0; k < 8; ++k) y[k] = pg8::silu_f(gf[k]) * x[k] * rinv;
        v4u ov; ov.x = pk2(y[0], y[1]); ov.y = pk2(y[2], y[3]); ov.z = pk2(y[4], y[5]); ov.w = pk2(y[6], y[7]);
        *(v4u*)(FIN + o) = ov;
    }
}
constexpr int NPHASE = 2 + 12 * NLAYER;
__host__ __device__ constexpr int layer_kind(int L) { return L == 1 ? 1 : (L == 2 ? 2 : 0); }
__host__ __device__ constexpr bool layer_moe(int L) { return (L & 1) != 0; }
__host__ __device__ constexpr bool phase_exists(int p) {
    if (p < 2) return true;
    const int L = (p - 2) / 12, s = (p - 2) % 12, k = layer_kind(L);
    if (L >= NLAYER) return false;
    switch (s) { case 0: return true; case 1: return k != 1; case 2: return true; case 3: return k == 2; case 4: return true; case 5: return true;
                 case 6: return layer_moe(L); case 7: return true; case 8: return true; case 9: return true; default: return false; }
}
__host__ __device__ constexpr int last_phase() { return 2 + 12 * (NLAYER - 1) + 9; }

#define IN(k) (lo <= (k) && (k) < hi)
#define SEAM(k) do { if (multi && (k) + 1 < hi && (k) != last_phase()) xcd_barrier(bar); } while (0)
template <int L>
__device__ __forceinline__ void layer_phases(Frame& F, const Args& args, const int lo, const int hi, const bool multi, const XcdBarrier& bar) {
    unsigned char* ws = args.ws;

        constexpr int pb = 2 + 12 * L, kind = layer_kind(L); constexpr bool moe = layer_moe(L);
        constexpr int ib = L == 0 ? 4 : (L == 1 ? 16 : (L == 2 ? 33 : 44));
        const float* ada0 = (const float*)(ws + WS_ADA) + (size_t)L * 5 * 6144;
        if (IN(pb + 0)) {
            if constexpr (kind == 1) {
                pg8::Gemm g{(const pg8::bf16_t*)(ws + WS_H), (const pg8::bf16_t*)(ws + W_L1_IN), NT, 4096, 1024, nullptr, 0};
                pg8::StaticOrder S; S.init(NT, 4096, F.G, (int)blockIdx.x);
                pg8::EpiGelu E{(pg8::bf16_t*)(ws + A_Z), 4096, args.in[23], (float*)(ws + WS_PS), 8};
                pg8::gemm_phase<pg8::EpiGelu, pg8::StaticOrder, true, true>(F.lds, g, S, E);
            } else {
                constexpr int N = kind == 0 ? 1536 : 6144;
                constexpr size_t wo = kind == 2 ? W_L2_IN : (L == 0 ? W_L0_QKV : W_L3_QKV);
                pg8::Gemm g{(const pg8::bf16_t*)(ws + WS_H), (const pg8::bf16_t*)(ws + wo), NT, N, 1024, nullptr, 0};
                pg8::StaticOrder S; S.init(NT, N, F.G, (int)blockIdx.x);
                pg8::EpiStore E{(pg8::bf16_t*)(ws + WS_ACT), N};
                pg8::gemm_phase<pg8::EpiStore, pg8::StaticOrder, true, true>(F.lds, g, S, E);
            }
            SEAM(pb + 0);
        }
        if constexpr (kind != 1) if (IN(pb + 1)) {
            if constexpr (kind == 0) attn_normrope(F, args.in[ib + 7], args.in[ib + 8]); else ret_rope(F);
            SEAM(pb + 1);
        }
        if (IN(pb + 2)) {
            if constexpr (kind == 0) attn_units(F, (char*)F.lds);
            else if constexpr (kind == 1) cmlp_mix(F, args.in[24], args.in[25], args.in[26], args.in[27]);
            else ret_scan(F, args.in[40]);
            SEAM(pb + 2);
        }
        if constexpr (kind == 2) if (IN(pb + 3)) { ret_finish(F); SEAM(pb + 3); }
        if (IN(pb + 4)) {
            constexpr int K = kind == 0 ? 1024 : 2048;
            constexpr size_t ao = kind == 0 ? A_O : (kind == 1 ? A_UV : A_FIN);
            constexpr size_t wo = kind == 1 ? W_L1_OUT : (kind == 2 ? W_L2_WO : (L == 0 ? W_L0_WO : W_L3_WO));
            pg8::Gemm g{(const pg8::bf16_t*)(ws + ao), (const pg8::bf16_t*)(ws + wo), NT, 1024, K, nullptr, 0};
            pg8::StaticOrder S; S.init(NT, 1024, F.G, (int)blockIdx.x);
            pg8::EpiRes E{(float*)(ws + WS_X), ada0 + 2 * 1024, kind == 1 ? args.in[29] : nullptr, DN_ALPHA};
            pg8::gemm_phase<pg8::EpiRes, pg8::StaticOrder, true, true>(F.lds, g, S, E);
            SEAM(pb + 4);
        }
        if (IN(pb + 5)) {
            RowP P{1, L, moe ? 1 : 0, args.in[ib + 2], args.in[ib + 3], moe ? (L == 1 ? args.in[30] : args.in[54]) : nullptr};
            row_phase(F, args, P); SEAM(pb + 5);
        }
        if constexpr (moe) if (IN(pb + 6)) { moe_scatter(F, L); SEAM(pb + 6); }
        if (IN(pb + 7)) {
            if constexpr (moe) {
                moe_layout(F, L);
                const LAS unsigned* T = (const LAS unsigned*)(F.lds + LDS_MOE_OFF); const int M = (int)T[0] * 256;
                pg8::Gemm g{(const pg8::bf16_t*)(ws + A_HP), (const pg8::bf16_t*)(ws + WM_GU), M, 7168, 1024, (const LAS unsigned char*)(T + 20), (size_t)7168 * 1024 * 2};
                pg8::StaticOrder S; S.init(M, 7168, F.G, (int)blockIdx.x);
                pg8::EpiSwiglu E{(pg8::bf16_t*)(ws + A_HM), FFN};
                pg8::gemm_phase<pg8::EpiSwiglu, pg8::StaticOrder, true, true>(F.lds, g, S, E);
            } else {
                pg8::Gemm g{(const pg8::bf16_t*)(ws + WS_H), (const pg8::bf16_t*)(ws + (L == 0 ? W_L0_GU : W_L2_GU)), NT, 7168, 1024, nullptr, 0};
                pg8::StaticOrder S; S.init(NT, 7168, F.G, (int)blockIdx.x);
                pg8::EpiSwiglu E{(pg8::bf16_t*)(ws + A_HID), FFN};
                pg8::gemm_phase<pg8::EpiSwiglu, pg8::StaticOrder, true, true>(F.lds, g, S, E);
            }
            SEAM(pb + 7);
        }
        if (IN(pb + 8)) {
            if constexpr (moe) {
                moe_layout(F, L);
                const LAS unsigned* T = (const LAS unsigned*)(F.lds + LDS_MOE_OFF); const int M = (int)T[0] * 256;
                pg8::Gemm g{(const pg8::bf16_t*)(ws + A_HM), (const pg8::bf16_t*)(ws + WM_DN), M, 1024, FFN, (const LAS unsigned char*)(T + 20), (size_t)1024 * FFN * 2};
                pg8::StaticOrder S; S.init(M, 1024, F.G, (int)blockIdx.x);
                pg8::EpiStore E{(pg8::bf16_t*)(ws + A_OM), 1024};
                pg8::gemm_phase<pg8::EpiStore, pg8::StaticOrder, true, true>(F.lds, g, S, E);
            } else {
                pg8::Gemm g{(const pg8::bf16_t*)(ws + A_HID), (const pg8::bf16_t*)(ws + (L == 0 ? W_L0_DN : W_L2_DN)), NT, 1024, FFN, nullptr, 0};
                pg8::StaticOrder S; S.init(NT, 1024, F.G, (int)blockIdx.x);
                pg8::EpiRes E{(float*)(ws + WS_X), ada0 + 5 * 1024, nullptr, DN_ALPHA};
                pg8::gemm_phase<pg8::EpiRes, pg8::StaticOrder, true, true>(F.lds, g, S, E);
            }
            SEAM(pb + 8);
        }
        if (IN(pb + 9)) {
            RowP P{2, L, moe ? 1 : 0, args.in[ib + 4], args.in[ib + 5], nullptr};
            row_phase(F, args, P);
            if constexpr (L == 1) convert_set_b(F, args);
            SEAM(pb + 9);
        }
    }
#undef IN
#undef SEAM

__global__ void __launch_bounds__(NWAVES * 64, 2) mega_fwd(Args args) {
    extern __shared__ __attribute__((aligned(16))) unsigned char lds[];
    Frame F;
    F.lds = (LAS unsigned char*)lds; F.ws = args.ws; F.ctl = (gu32*)(args.ws + WS_CTL);
    F.tid = threadIdx.x; F.lane = F.tid & 63; F.wave = __builtin_amdgcn_readfirstlane(F.tid >> 6);
    F.G = gridDim.x; { const int bx = blockIdx.x; F.vcu = (F.G % 8 == 0) ? (bx % 8) * (F.G / 8) + bx / 8 : bx; }
    volatile LAS unsigned* MISC = (volatile LAS unsigned*)(F.lds + MISC_OFF);
    if (F.tid < 16) MISC[F.tid] = 0u;
    __syncthreads();
    const int lo = args.ph_lo, hi = args.ph_hi;
    const bool multi = (hi - lo) > 1;
    XcdBarrier bar; bar.bar = (unsigned*)(F.ctl + CW_BAR); bar.x = 0; bar.st = nullptr;
    if (multi) bar = xcd_barrier_post((unsigned*)(F.ctl + CW_BAR), MISC);
#define IN(k) (lo <= (k) && (k) < hi)
#define SEAM(k) do { if (multi && (k) + 1 < hi && (k) != last_phase()) xcd_barrier(bar); } while (0)
    unsigned char* ws = args.ws;

    if (IN(0)) { ada_phase(F, args); convert_set_a(F, args); SEAM(0); }
    if (IN(1)) { RowP P{0, 0, 0, nullptr, nullptr, nullptr}; row_phase(F, args, P); SEAM(1); }

    layer_phases<0>(F, args, lo, hi, multi, bar);
    layer_phases<1>(F, args, lo, hi, multi, bar);
    layer_phases<2>(F, args, lo, hi, multi, bar);
    layer_phases<3>(F, args, lo, hi, multi, bar);
#undef IN
#undef SEAM
}

extern "C" void kernel_launch(void* const* d_in, const int* in_sizes, int n_in, void* d_out, int out_size, void* d_ws, size_t ws_size, hipStream_t stream) {
    static int grid = 0;
    if (grid == 0) {
        if (n_in != 57 || out_size != NBATCH * SEQ * DM || ws_size < WS_END) { fprintf(stderr, "kernel_launch: unexpected shapes: n_in %d out %d ws %zu (need %zu)\n", n_in, out_size, ws_size, (size_t)WS_END); grid = -1; return; }
        int dev = 0, cus = 0;
        if (hipGetDevice(&dev) != hipSuccess || hipDeviceGetAttribute(&cus, hipDeviceAttributeMultiprocessorCount, dev) != hipSuccess) { grid = -1; return; }
        if (hipFuncSetAttribute((const void*)mega_fwd, hipFuncAttributeMaxDynamicSharedMemorySize, LDS_BYTES) != hipSuccess) { fprintf(stderr, "kernel_launch: hipFuncSetAttribute failed\n"); grid = -1; return; }
        int per_cu = 0;
        if (hipOccupancyMaxActiveBlocksPerMultiprocessor(&per_cu, (const void*)mega_fwd, NWAVES * 64, LDS_BYTES) != hipSuccess || per_cu < 1) fprintf(stderr, "kernel_launch: occupancy query says %d\n", per_cu);
        (void)hipGetLastError();
        grid = cus;
    }
    if (grid < 0) return;
    if (hipMemsetAsync((char*)d_ws + WS_CTL, 0, CTL_ZERO_BYTES, stream) != hipSuccess) return;
    Args a{};
    for (int i = 0; i < 57; ++i) a.in[i] = (const float*)d_in[i];
    a.out = (float*)d_out; a.ws = (unsigned char*)d_ws;
#if SINGLE_LAUNCH
    a.ph_lo = 0; a.ph_hi = NPHASE;
    hipLaunchKernelGGL(mega_fwd, dim3(grid), dim3(NWAVES * 64), LDS_BYTES, stream, a);
#else
    for (int p = 0; p < NPHASE; ++p) {
        if (!phase_exists(p)) continue;
        a.ph_lo = p; a.ph_hi = p + 1;
        hipLaunchKernelGGL(mega_fwd, dim3(grid), dim3(NWAVES * 64), LDS_BYTES, stream, a);
    }
#endif
    const hipError_t le = hipPeekAtLastError();
    if (le != hipSuccess) fprintf(stderr, "kernel_launch: launch failed: %s\n", hipGetErrorName(le));
}
```

```cpp
#include <hip/hip_runtime.h>
#include <hip/hip_bf16.h>
#include <cstdio>
#include <cstdint>

#ifndef SINGLE_LAUNCH
#define SINGLE_LAUNCH 1
#endif

namespace pg8 {
#define PG8_LAS __attribute__((address_space(3)))
typedef unsigned short bf16_t;
typedef short bf16x8 __attribute__((ext_vector_type(8)));
typedef float f32x4 __attribute__((ext_vector_type(4)));
typedef unsigned u32x4 __attribute__((ext_vector_type(4)));
constexpr int BM = 256, BK = 64, HALF = 128, HTB = HALF * BK * 2  , STAGE_BYTES = 8 * HTB, NXCD = 8, WGM = 8;

__host__ __device__ __forceinline__ int lds_byte(int r, int c) { const int st = (r >> 4) * 2 + (c >> 5), rr = r & 15, cc = c & 31, ob = rr * 64 + cc * 2; return st * 1024 + (ob ^ (((ob >> 9) & 1) << 5)); }
__host__ __device__ __forceinline__ void stage_rc(int b, int& R, int& C) { const int st = b / 1024, sb = b % 1024, swz = sb ^ (((sb >> 9) & 1) << 5); R = (st >> 1) * 16 + swz / 64; C = (st & 1) * 32 + (swz % 64) / 2; }
__host__ __device__ __forceinline__ int perm32(int rho) { const int n = rho >> 4, i = rho & 15; return 8 * (i >> 2) + 4 * n + (i & 3); }

struct Unit { int pm, pn; };
struct Gemm { const bf16_t* A; const bf16_t* Bt; int M, N, K; const PG8_LAS unsigned char* texp; size_t estride; };

struct StaticOrder {
    int nM, nN, nwg, G, c;
    __host__ __device__ void init(int M, int N, int G_, int c_) { nM = M / BM; nN = N / BM; nwg = nM * nN; G = G_; c = c_; }
    __host__ __device__ bool next(int i, Unit& u) const {
        const long L = (long)i * G + c; if (L >= nwg) return false;
        int wgid = (int)L; { const int q = nwg / NXCD, r = nwg % NXCD, xcd = wgid % NXCD, off = wgid / NXCD; wgid = (xcd < r ? xcd * (q + 1) : r * (q + 1) + (xcd - r) * q) + off; }
        const int nig = WGM * nN, gid = wgid / nig, fm = gid * WGM, gsz = (nM - fm) < WGM ? (nM - fm) : WGM;
        u.pm = fm + ((wgid % nig) % gsz); u.pn = (wgid % nig) / gsz; return true;
    }
    __device__ __forceinline__ void a_ready(const Unit&) const {}
    __device__ __forceinline__ void done(const Unit&) const {}
};

__device__ __forceinline__ unsigned cvt_pk_bf16(float lo, float hi) { unsigned r; asm volatile("v_cvt_pk_bf16_f32 %0, %1, %2" : "=v"(r) : "v"(lo), "v"(hi)); return r; }
__device__ __forceinline__ float gelu_tanh(float x) {
    const float u = x * (0.7978845608f + 0.0356774081f * x * x);
    const float e = __builtin_amdgcn_exp2f(-2.885390082f * u);
    return x * __builtin_amdgcn_rcpf(1.0f + e);
}
__device__ __forceinline__ float silu_f(float x) { return x * __builtin_amdgcn_rcpf(1.0f + __builtin_amdgcn_exp2f(-1.4426950409f * x)); }

struct EpiStore {
    static constexpr bool PERM = true, AFTER_DRAIN = false;
    bf16_t* O; int ldc;
    __device__ __forceinline__ void operator()(const f32x4 (&acc)[2][2][4][2], const Unit& u, int wr, int wc, int fr, int fq) const {
        const int row0 = u.pm * BM + wr * 64 + fr, col0 = u.pn * BM + wc * 32 + 8 * fq;
#pragma unroll
        for (int ai = 0; ai < 2; ++ai)
#pragma unroll
            for (int m = 0; m < 4; ++m) { bf16_t* rowp = O + (size_t)(row0 + ai * HALF + m * 16) * ldc + col0;
#pragma unroll
                for (int bj = 0; bj < 2; ++bj) { const f32x4 v0 = acc[ai][bj][m][0], v1 = acc[ai][bj][m][1];
                    u32x4 w; w.x = cvt_pk_bf16(v0[0], v0[1]); w.y = cvt_pk_bf16(v0[2], v0[3]); w.z = cvt_pk_bf16(v1[0], v1[1]); w.w = cvt_pk_bf16(v1[2], v1[3]);
                    *(u32x4*)(rowp + bj * HALF) = w; } }
    }
};

struct EpiGelu {
    static constexpr bool PERM = true, AFTER_DRAIN = false;
    bf16_t* O; int ldc; const float* bias; float* PS; int stat_pn0;
    __device__ __forceinline__ void operator()(const f32x4 (&acc)[2][2][4][2], const Unit& u, int wr, int wc, int fr, int fq) const {
        const int row0 = u.pm * BM + wr * 64 + fr, col0 = u.pn * BM + wc * 32 + 8 * fq;
        f32x4 bv[2][2];
#pragma unroll
        for (int bj = 0; bj < 2; ++bj)
#pragma unroll
            for (int n = 0; n < 2; ++n) bv[bj][n] = *(const f32x4*)(bias + col0 + bj * HALF + 4 * n);
        const bool do_stat = u.pn >= stat_pn0;
#pragma unroll
        for (int ai = 0; ai < 2; ++ai)
#pragma unroll
            for (int m = 0; m < 4; ++m) { const int row = row0 + ai * HALF + m * 16; bf16_t* rowp = O + (size_t)row * ldc + col0;
                float s = 0.f, q = 0.f;
#pragma unroll
                for (int bj = 0; bj < 2; ++bj) { f32x4 v0 = acc[ai][bj][m][0] + bv[bj][0], v1 = acc[ai][bj][m][1] + bv[bj][1];
#pragma unroll
                    for (int i = 0; i < 4; ++i) { v0[i] = gelu_tanh(v0[i]); v1[i] = gelu_tanh(v1[i]); s += v0[i] + v1[i]; q += v0[i] * v0[i] + v1[i] * v1[i]; }
                    u32x4 w; w.x = cvt_pk_bf16(v0[0], v0[1]); w.y = cvt_pk_bf16(v0[2], v0[3]); w.z = cvt_pk_bf16(v1[0], v1[1]); w.w = cvt_pk_bf16(v1[2], v1[3]);
                    *(u32x4*)(rowp + bj * HALF) = w; }
                s += __shfl_xor(s, 16); s += __shfl_xor(s, 32); q += __shfl_xor(q, 16); q += __shfl_xor(q, 32);
                if (do_stat && fq == 0) { float* p = PS + ((size_t)row * 32 + (u.pn - stat_pn0) * 4 + wc) * 2; p[0] = s; p[1] = q; } }
    }
};

struct EpiSwiglu {
    static constexpr bool PERM = true, AFTER_DRAIN = false;
    bf16_t* O; int ldc;
    __device__ __forceinline__ void operator()(const f32x4 (&acc)[2][2][4][2], const Unit& u, int wr, int wc, int fr, int fq) const {
        const int row0 = u.pm * BM + wr * 64 + fr, col0 = u.pn * HALF + wc * 32 + 8 * fq;
#pragma unroll
        for (int ai = 0; ai < 2; ++ai)
#pragma unroll
            for (int m = 0; m < 4; ++m) { bf16_t* rowp = O + (size_t)(row0 + ai * HALF + m * 16) * ldc + col0;
                float h[8];
#pragma unroll
                for (int n = 0; n < 2; ++n)
#pragma unroll
                    for (int i = 0; i < 4; ++i) h[n * 4 + i] = silu_f(acc[ai][0][m][n][i]) * acc[ai][1][m][n][i];
                u32x4 w; w.x = cvt_pk_bf16(h[0], h[1]); w.y = cvt_pk_bf16(h[2], h[3]); w.z = cvt_pk_bf16(h[4], h[5]); w.w = cvt_pk_bf16(h[6], h[7]);
                *(u32x4*)rowp = w; }
    }
};

struct EpiRes {
    static constexpr bool PERM = false, AFTER_DRAIN = false;
    float* X; const float* gate; const float* bias; float alpha;
    __device__ __forceinline__ void operator()(const f32x4 (&acc)[2][2][4][2], const Unit& u, int wr, int wc, int fr, int fq) const {
        const int within = u.pm % 17, cidx = within == 0 ? 4 : u.pm / 17;
        const int col0 = u.pn * BM + wc * 32 + 4 * fq; const float* gp = gate + (size_t)cidx * 6144;
        f32x4 gv[2][2], bv[2][2];
#pragma unroll
        for (int bj = 0; bj < 2; ++bj)
#pragma unroll
            for (int n = 0; n < 2; ++n) { gv[bj][n] = *(const f32x4*)(gp + col0 + bj * HALF + n * 16);
                bv[bj][n] = bias ? *(const f32x4*)(bias + col0 + bj * HALF + n * 16) : (f32x4){0.f, 0.f, 0.f, 0.f}; }
#pragma unroll
        for (int ai = 0; ai < 2; ++ai)
#pragma unroll
            for (int m = 0; m < 4; ++m) { float* rowp = X + (size_t)(u.pm * BM + ai * HALF + wr * 64 + m * 16 + fr) * 1024 + col0;
#pragma unroll
                for (int bj = 0; bj < 2; ++bj)
#pragma unroll
                    for (int n = 0; n < 2; ++n) { f32x4* p = (f32x4*)(rowp + bj * HALF + n * 16); const f32x4 xo = *p;
                        *p = xo * alpha + gv[bj][n] * (acc[ai][bj][m][n] + bv[bj][n]); } }
    }
};

template <class Epi, class Sched, bool ALIGN_EPI = false, bool SP2 = false>
__device__ __forceinline__ void gemm_phase(PG8_LAS unsigned char* lds, const Gemm g, const Sched& S, const Epi& E) {
    const int tid = threadIdx.x, wid = __builtin_amdgcn_readfirstlane(tid >> 6), lane = tid & 63, wr = wid >> 2, wc = wid & 3, fr = lane & 15, fq = lane >> 4;
    const int K = g.K, nt = K / BK;
    unsigned voffA[2], voffB[2];
#pragma unroll
    for (int i = 0; i < 2; ++i) { int R, C; stage_rc(tid * 16 + i * 8192, R, C); const int Rb = Epi::PERM ? ((R & ~31) + perm32(R & 31)) : R;
        voffA[i] = (unsigned)(R * K + C) * 2u; voffB[i] = (unsigned)(Rb * K + C) * 2u; }
    const size_t kstep = (size_t)(BK * 2);
    const size_t hstep = (size_t)HALF * K * 2;
    const size_t tstep = 2 * hstep;
    const unsigned ldsw = (unsigned)wid * 1024u;
    const int aoff = lds_byte(wr * 64 + fr, fq * 8), boff = lds_byte(wc * 32 + fr, fq * 8);
#define PG8_EOFF(u) (g.texp ? (size_t)g.texp[(u).pm] * g.estride : (size_t)0)
#define PG8_SA(b, h) (((b) * 2 + (h)) * HTB)
#define PG8_SB(b, h) ((4 + (b) * 2 + (h)) * HTB)
#define PG8_STAGE(bufoff, gbase, voff) do { _Pragma("unroll") for (int _i = 0; _i < 2; ++_i) \
        __builtin_amdgcn_global_load_lds((const unsigned*)((const char*)(gbase) + (voff)[_i]), (PG8_LAS unsigned*)(lds + (bufoff) + ldsw + _i * 8192), 16, 0, 0); } while (0)
#define PG8_LDA(dst, b, h) do { _Pragma("unroll") for (int m = 0; m < 4; ++m) _Pragma("unroll") for (int k = 0; k < 2; ++k) dst[m][k] = *(const PG8_LAS bf16x8*)(lds + PG8_SA(b, h) + aoff + m * 2048 + k * 1024); } while (0)
#define PG8_LDB(dst, b, h) do { _Pragma("unroll") for (int n = 0; n < 2; ++n) _Pragma("unroll") for (int k = 0; k < 2; ++k) dst[n][k] = *(const PG8_LAS bf16x8*)(lds + PG8_SB(b, h) + boff + n * 2048 + k * 1024); } while (0)
#define PG8_MMA(ai, bj, At, Bt) do { __builtin_amdgcn_s_setprio(1); _Pragma("unroll") for (int m = 0; m < 4; ++m) _Pragma("unroll") for (int n = 0; n < 2; ++n) _Pragma("unroll") for (int k = 0; k < 2; ++k) \
        acc[ai][bj][m][n] = __builtin_amdgcn_mfma_f32_16x16x32_bf16(Bt[n][k], At[m][k], acc[ai][bj][m][n], 0, 0, 0); __builtin_amdgcn_s_setprio(0); } while (0)
#define PG8_WAIT_V(n) asm volatile("s_waitcnt vmcnt(" #n ")" ::: "memory")
#define PG8_WAIT_L(n) asm volatile("s_waitcnt lgkmcnt(" #n ")" ::: "memory")
#define PG8_BAR __builtin_amdgcn_s_barrier()
#define PG8_SCHED __builtin_amdgcn_sched_barrier(0)
    Unit cur, nxt; int ui = 0;
    if (!S.next(0, cur)) return;
    f32x4 acc[2][2][4][2];
#pragma unroll
    for (int a = 0; a < 2; ++a)
#pragma unroll
        for (int b = 0; b < 2; ++b)
#pragma unroll
            for (int m = 0; m < 4; ++m)
#pragma unroll
                for (int n = 0; n < 2; ++n) acc[a][b][m][n] = (f32x4){0.f, 0.f, 0.f, 0.f};
    bf16x8 At[4][2], B0[2][2], B1[2][2];
    const char* cA = (const char*)g.A + (size_t)cur.pm * tstep; const char* cB = (const char*)g.Bt + (size_t)cur.pn * tstep + PG8_EOFF(cur);
    S.a_ready(cur);
    if constexpr (SP2) {
        PG8_STAGE(PG8_SB(0, 0), cB, voffB); PG8_STAGE(PG8_SB(0, 1), cB + hstep, voffB); PG8_STAGE(PG8_SA(0, 0), cA, voffA); PG8_STAGE(PG8_SA(0, 1), cA + hstep, voffA);
        if (wr == 1) PG8_BAR;
        PG8_WAIT_V(2); PG8_BAR;
        PG8_STAGE(PG8_SB(1, 0), cB + kstep, voffB); PG8_STAGE(PG8_SA(1, 0), cA + kstep, voffA); PG8_STAGE(PG8_SB(1, 1), cB + hstep + kstep, voffB);
        PG8_WAIT_V(6); PG8_BAR;
    } else {
        PG8_STAGE(PG8_SB(0, 0), cB, voffB); PG8_STAGE(PG8_SA(0, 0), cA, voffA); PG8_STAGE(PG8_SB(0, 1), cB + hstep, voffB); PG8_STAGE(PG8_SA(0, 1), cA + hstep, voffA);
        if (wr == 1) PG8_BAR;
        PG8_WAIT_V(4); PG8_BAR;
        PG8_STAGE(PG8_SB(1, 0), cB + kstep, voffB); PG8_STAGE(PG8_SA(1, 0), cA + kstep, voffA); PG8_STAGE(PG8_SB(1, 1), cB + hstep + kstep, voffB);
        PG8_WAIT_V(6); PG8_BAR;
    }
    for (;;) {
        const bool has_next = S.next(ui + 1, nxt);
        const char* nA = has_next ? (const char*)g.A + (size_t)nxt.pm * tstep : cA; const char* nB = has_next ? (const char*)g.Bt + (size_t)nxt.pn * tstep + PG8_EOFF(nxt) : cB;
        for (int t = 0; t < nt; t += 2) {
            const bool last = (t == nt - 2);
            const char* a1 = cA + (size_t)(t + 1) * kstep;
            const char* a2 = last ? nA : cA + (size_t)(t + 2) * kstep; const char* b2 = last ? nB : cB + (size_t)(t + 2) * kstep;
            const char* a3 = a2 + kstep; const char* b3 = b2 + kstep;
            if (last && has_next) S.a_ready(nxt);
            if constexpr (SP2) {
            PG8_LDB(B0, 0, 0); PG8_LDB(B1, 0, 1); PG8_SCHED; PG8_LDA(At, 0, 0); PG8_STAGE(PG8_SA(1, 1), a1 + hstep, voffA);
            PG8_WAIT_V(8); PG8_WAIT_L(0); PG8_BAR; PG8_MMA(0, 0, At, B0); PG8_MMA(0, 1, At, B1); PG8_BAR; PG8_SCHED;
            PG8_LDA(At, 0, 1); PG8_STAGE(PG8_SB(0, 0), b2, voffB); PG8_STAGE(PG8_SB(0, 1), b2 + hstep, voffB); PG8_STAGE(PG8_SA(0, 0), a2, voffA);
            PG8_WAIT_V(8); PG8_WAIT_L(0); PG8_BAR; PG8_MMA(1, 0, At, B0); PG8_MMA(1, 1, At, B1); PG8_BAR; PG8_SCHED;
            PG8_LDB(B0, 1, 0); PG8_LDB(B1, 1, 1); PG8_SCHED; PG8_LDA(At, 1, 0); PG8_STAGE(PG8_SA(0, 1), a2 + hstep, voffA);
            PG8_WAIT_V(8); PG8_WAIT_L(0); PG8_BAR; PG8_MMA(0, 0, At, B0); PG8_MMA(0, 1, At, B1); PG8_BAR; PG8_SCHED;
            PG8_LDA(At, 1, 1); PG8_STAGE(PG8_SB(1, 0), b3, voffB); PG8_STAGE(PG8_SB(1, 1), b3 + hstep, voffB); PG8_STAGE(PG8_SA(1, 0), a3, voffA);
            PG8_WAIT_V(8); PG8_WAIT_L(0); PG8_BAR; PG8_MMA(1, 0, At, B0); PG8_MMA(1, 1, At, B1); PG8_BAR; PG8_SCHED;
            } else {
            PG8_LDB(B0, 0, 0); PG8_SCHED; PG8_LDA(At, 0, 0); PG8_STAGE(PG8_SA(1, 1), a1 + hstep, voffA);
            PG8_WAIT_L(8); PG8_BAR; PG8_WAIT_L(0); PG8_MMA(0, 0, At, B0); PG8_BAR; PG8_SCHED;
            PG8_LDB(B1, 0, 1); PG8_STAGE(PG8_SB(0, 0), b2, voffB);
            PG8_BAR; PG8_WAIT_L(0); PG8_MMA(0, 1, At, B1); PG8_BAR;
            PG8_LDA(At, 0, 1); PG8_STAGE(PG8_SA(0, 0), a2, voffA);
            PG8_BAR; PG8_WAIT_L(0); PG8_MMA(1, 0, At, B0); PG8_BAR; PG8_SCHED;
            PG8_STAGE(PG8_SB(0, 1), b2 + hstep, voffB);
            PG8_WAIT_V(6); PG8_BAR; PG8_MMA(1, 1, At, B1); PG8_BAR;
            PG8_LDB(B0, 1, 0); PG8_SCHED; PG8_LDA(At, 1, 0); PG8_STAGE(PG8_SA(0, 1), a2 + hstep, voffA);
            PG8_WAIT_L(8); PG8_BAR; PG8_WAIT_L(0); PG8_MMA(0, 0, At, B0); PG8_BAR; PG8_SCHED;
            PG8_LDB(B1, 1, 1); PG8_STAGE(PG8_SB(1, 0), b3, voffB);
            PG8_BAR; PG8_WAIT_L(0); PG8_MMA(0, 1, At, B1); PG8_BAR;
            PG8_LDA(At, 1, 1); PG8_STAGE(PG8_SA(1, 0), a3, voffA);
            PG8_BAR; PG8_WAIT_L(0); PG8_MMA(1, 0, At, B0); PG8_BAR; PG8_SCHED;
            PG8_STAGE(PG8_SB(1, 1), b3 + hstep, voffB);
            PG8_WAIT_V(6); PG8_BAR; PG8_MMA(1, 1, At, B1); PG8_BAR;
            }
        }
        if constexpr (ALIGN_EPI) { if (wr == 0) PG8_BAR; }
        if constexpr (!Epi::AFTER_DRAIN) { E(acc, cur, wr, wc, fr, fq); S.done(cur); }
        if (!has_next) break;
#pragma unroll
        for (int a = 0; a < 2; ++a)
#pragma unroll
            for (int b = 0; b < 2; ++b)
#pragma unroll
                for (int m = 0; m < 4; ++m)
#pragma unroll
                    for (int n = 0; n < 2; ++n) acc[a][b][m][n] = (f32x4){0.f, 0.f, 0.f, 0.f};
        cur = nxt; cA = nA; cB = nB; ++ui;
        if constexpr (ALIGN_EPI) { if (wr == 1) PG8_BAR; }
    }
    PG8_WAIT_V(0);
    if constexpr (!ALIGN_EPI) { if (wr == 0) PG8_BAR; }
    PG8_BAR;
    if constexpr (Epi::AFTER_DRAIN) { E.fused(acc, cur, wr, wc, fr, fq, lds, wid, lane); S.done(cur); }
#undef PG8_SA
#undef PG8_EOFF
#undef PG8_SB
#undef PG8_STAGE
#undef PG8_LDA
#undef PG8_LDB
#undef PG8_MMA
#undef PG8_WAIT_V
#undef PG8_WAIT_L
#undef PG8_BAR
#undef PG8_SCHED
}
}
namespace att {
using bf16 = __hip_bfloat16;
constexpr int   D = 128, NW = 8, QBLK = 32, KVBLK = 64;
constexpr float SCALE = 0.088388347648318440f;
constexpr float THR = 8.f;
constexpr int SDEPTH = 2;
constexpr size_t SHM_V = KVBLK * D * 2, SHM_K = KVBLK * D * 2, SHM_ATTN = 2 * SHM_V + 2 * SHM_K + NW * 64 * 4;
using bf16x8 = __attribute__((ext_vector_type(8))) short;
using s16x4  = __attribute__((ext_vector_type(4))) short;
using f32x16 = __attribute__((ext_vector_type(16))) float;
using f32x8  = __attribute__((ext_vector_type(8))) float;
using u32x4  = __attribute__((ext_vector_type(4))) unsigned;
#define KSWZ(row, colB) ((row) * 256 + ((colB) ^ (((row) & 7) << 4)))
#define SBAR() __builtin_amdgcn_sched_barrier(0)
__device__ __forceinline__ int crow(int r, int hi) { return (r & 3) + 8 * (r >> 2) + 4 * hi; }
__device__ __forceinline__ unsigned cvtpk(float lo, float hi) {
  unsigned r; asm volatile("v_cvt_pk_bf16_f32 %0, %1, %2" : "=v"(r) : "v"(lo), "v"(hi)); return r;
}
template <typename TIn> struct Stage;
template <> struct Stage<bf16>  { using T = bf16x8;
  __device__ static __forceinline__ T ld8(const bf16* p) { return *reinterpret_cast<const bf16x8*>(p); }
  __device__ static __forceinline__ bf16x8 tobf(T x) { return x; } };
template <> struct Stage<float> { using T = f32x8;
  __device__ static __forceinline__ T ld8(const float* p) { return *reinterpret_cast<const f32x8*>(p); }
  __device__ static __forceinline__ bf16x8 tobf(T x) {
    u32x4 w = {cvtpk(x[0], x[1]), cvtpk(x[2], x[3]), cvtpk(x[4], x[5]), cvtpk(x[6], x[7])}; return *reinterpret_cast<bf16x8*>(&w); } };

__device__ __forceinline__ void partialSM(f32x16& p0, f32x16& p1, float& m_reg, float& mn, float& alpha) {
  constexpr float C = SCALE * 1.4426950408889634f;
  float pmax = p0[0]; for (int r = 1; r < 16; ++r) pmax = fmaxf(pmax, p0[r]); for (int r = 0; r < 16; ++r) pmax = fmaxf(pmax, p1[r]);
  { auto rr = __builtin_amdgcn_permlane32_swap(__float_as_uint(pmax), __float_as_uint(pmax), false, false);
    pmax = fmaxf(__uint_as_float(rr[0]), __uint_as_float(rr[1])); }
  if (__builtin_expect(__all(pmax - m_reg <= THR / SCALE), 1)) { mn = m_reg; alpha = 1.f; }
  else { mn = fmaxf(m_reg, pmax); alpha = __builtin_amdgcn_exp2f((m_reg - mn) * C); m_reg = mn; }
  float mnC = -mn * C;
  for (int r = 0; r < 16; ++r) p0[r] = fmaf(p0[r], C, mnC); for (int r = 0; r < 16; ++r) p1[r] = fmaf(p1[r], C, mnC);
  for (int r = 0; r < 16; ++r) p0[r] = __builtin_amdgcn_exp2f(p0[r]);
}
__device__ __forceinline__ void finishSM(f32x16& p0, f32x16& p1, float alpha, float& l_reg, bf16x8& pa0, bf16x8& pa1, bf16x8& pa2, bf16x8& pa3) {
  for (int r = 0; r < 16; ++r) p1[r] = __builtin_amdgcn_exp2f(p1[r]);
  float ps = 0; for (int r = 0; r < 16; ++r) ps += p0[r]; for (int r = 0; r < 16; ++r) ps += p1[r];
  { auto rr = __builtin_amdgcn_permlane32_swap(__float_as_uint(ps), __float_as_uint(ps), false, false);
    ps = __uint_as_float(rr[0]) + __uint_as_float(rr[1]); }
  l_reg = l_reg * alpha + ps;
#define PK4(P, BASE, OUT) do { unsigned a0 = cvtpk(P[BASE + 0], P[BASE + 1]), a1 = cvtpk(P[BASE + 2], P[BASE + 3]);   \
    unsigned b0 = cvtpk(P[BASE + 4], P[BASE + 5]), b1 = cvtpk(P[BASE + 6], P[BASE + 7]);                              \
    auto r0 = __builtin_amdgcn_permlane32_swap(a0, b0, false, false); auto r1 = __builtin_amdgcn_permlane32_swap(a1, b1, false, false); \
    u32x4 w = {r0[0], r1[0], r0[1], r1[1]}; OUT = *reinterpret_cast<bf16x8*>(&w); } while (0)
  PK4(p0, 0, pa0); PK4(p0, 8, pa1); PK4(p1, 0, pa2); PK4(p1, 8, pa3);
#undef PK4
}
__device__ __forceinline__ void qkt(f32x16& p0, f32x16& p1, const bf16* Ks, const bf16x8* qr, int r32, int hi) {
  p0 = f32x16{}; p1 = f32x16{};
  for (int d0 = 0; d0 < 8; ++d0) { int cb = (d0 * 16 + hi * 8) * 2;
    bf16x8 b0 = *reinterpret_cast<const bf16x8*>((const char*)Ks + KSWZ(r32, cb));
    bf16x8 b1 = *reinterpret_cast<const bf16x8*>((const char*)Ks + KSWZ(32 + r32, cb));
    p0 = __builtin_amdgcn_mfma_f32_32x32x16_bf16(b0, qr[d0], p0, 0, 0, 0);
    p1 = __builtin_amdgcn_mfma_f32_32x32x16_bf16(b1, qr[d0], p1, 0, 0, 0); }
}
__device__ __forceinline__ int v_st(int k, int c) { const int kk = (k & ~0xC) | ((k & 4) << 1) | ((k & 8) >> 1); return ((kk >> 3) * 4 + (c >> 5)) * 512 + ((kk & 7) * 32 + (c & 31)) * 2; }
__device__ __forceinline__ int v_rd_base(int lane) { return ((lane & 3) << 3) | (((lane >> 2) & 3) << 6) | (((lane >> 4) & 1) << 5) | (((lane >> 5) & 1) << 8); }
constexpr int v_rd_off(int d0, int ks, int half) { return d0 * 512 + ks * 4096 + half * 2048; }
template <int OFF> __device__ __forceinline__ s16x4 tr_read(int vb) {
  s16x4 r; asm volatile("ds_read_b64_tr_b16 %0, %1 offset:%2" : "=&v"(r) : "v"(vb), "i"(OFF) : "memory"); return r;
}
template <int D0> __device__ __forceinline__ void pv_one(f32x16& od, int vb, bf16x8 pa0, bf16x8 pa1, bf16x8 pa2, bf16x8 pa3) {
  const s16x4 l0 = tr_read<v_rd_off(D0, 0, 0)>(vb), h0 = tr_read<v_rd_off(D0, 0, 1)>(vb), l1 = tr_read<v_rd_off(D0, 1, 0)>(vb), h1 = tr_read<v_rd_off(D0, 1, 1)>(vb);
  const s16x4 l2 = tr_read<v_rd_off(D0, 2, 0)>(vb), h2 = tr_read<v_rd_off(D0, 2, 1)>(vb), l3 = tr_read<v_rd_off(D0, 3, 0)>(vb), h3 = tr_read<v_rd_off(D0, 3, 1)>(vb);
  asm volatile("s_waitcnt lgkmcnt(0)" ::: "memory"); SBAR();
#define PK(L, H) (bf16x8){L[0], L[1], L[2], L[3], H[0], H[1], H[2], H[3]}
  od = __builtin_amdgcn_mfma_f32_32x32x16_bf16(pa0, PK(l0, h0), od, 0, 0, 0);
  od = __builtin_amdgcn_mfma_f32_32x32x16_bf16(pa1, PK(l1, h1), od, 0, 0, 0);
  od = __builtin_amdgcn_mfma_f32_32x32x16_bf16(pa2, PK(l2, h2), od, 0, 0, 0);
  od = __builtin_amdgcn_mfma_f32_32x32x16_bf16(pa3, PK(l3, h3), od, 0, 0, 0);
#undef PK
}
__device__ __forceinline__ void pv_d0(f32x16* o, int vb, bf16x8 pa0, bf16x8 pa1, bf16x8 pa2, bf16x8 pa3) {
  pv_one<0>(o[0], vb, pa0, pa1, pa2, pa3); pv_one<1>(o[1], vb, pa0, pa1, pa2, pa3); pv_one<2>(o[2], vb, pa0, pa1, pa2, pa3); pv_one<3>(o[3], vb, pa0, pa1, pa2, pa3);
}

template <int LDQ, int LDK, int LDO>
__device__ __forceinline__ void attn_dense_body(const bf16* Qb, const bf16* Kh, const bf16* Vh,
                                                unsigned short* Ob, int seq, char* lds) {
  using TQ = bf16;
  using St = Stage<bf16>; using SQ = Stage<TQ>;
  const int tid = threadIdx.x, wid = tid >> 6, lane = tid & 63, r32 = lane & 31, hi = lane >> 5;
  bf16* V_lds = (bf16*)lds; bf16* K_lds = (bf16*)(lds + 2 * SHM_V);
  float* ws = (float*)(lds + 2 * SHM_V + 2 * SHM_K) + wid * 64; float* li_l = ws; float* al_l = ws + 32;
  float m_reg = -1e30f, l_reg = 0; f32x16 o[4] = {}; bf16x8 qr[8];
  const TQ* Qw = Qb + (long)(wid * QBLK + r32) * LDQ + hi * 8;
#pragma unroll
  for (int d0 = 0; d0 < 8; ++d0) qr[d0] = SQ::tobf(SQ::ld8(Qw + d0 * 16));
  const int sr = tid >> 4, sc = (tid & 15) * 8, vst0 = v_st(sr, sc), vst1 = v_st(32 + sr, sc);
  const int vb0 = (int)(uintptr_t)V_lds + v_rd_base(lane);
  struct { typename St::T vs0, vs1, ks0, ks1; } sr_[SDEPTH];
#define SLOAD(i, k0) do { sr_[i].vs0 = St::ld8(&Vh[(long)((k0) + sr) * LDK + sc]); sr_[i].vs1 = St::ld8(&Vh[(long)((k0) + 32 + sr) * LDK + sc]); \
    sr_[i].ks0 = St::ld8(&Kh[(long)((k0) + sr) * LDK + sc]); sr_[i].ks1 = St::ld8(&Kh[(long)((k0) + 32 + sr) * LDK + sc]); } while (0)
#define SWRITE(b, i) do { *(bf16x8*)((char*)V_lds + (b) * SHM_V + vst0) = St::tobf(sr_[i].vs0);          \
    *(bf16x8*)((char*)V_lds + (b) * SHM_V + vst1) = St::tobf(sr_[i].vs1); int kc = sc * 2;               \
    *(bf16x8*)((char*)K_lds + (b) * SHM_K + KSWZ(sr, kc)) = St::tobf(sr_[i].ks0);                       \
    *(bf16x8*)((char*)K_lds + (b) * SHM_K + KSWZ(32 + sr, kc)) = St::tobf(sr_[i].ks1); } while (0)
#define SWAIT() do { if constexpr (SDEPTH == 2) asm volatile("s_waitcnt vmcnt(4)" ::: "memory"); else asm volatile("s_waitcnt vmcnt(0)" ::: "memory"); } while (0)
#define RESC(a) do { if (__any((a) < 1.f)) { if (hi == 0) al_l[r32] = (a); asm volatile("s_waitcnt lgkmcnt(0)" ::: "memory"); \
    for (int d = 0; d < 4; ++d) for (int r = 0; r < 16; ++r) o[d][r] *= al_l[crow(r, hi)]; } } while (0)
  f32x16 pA0, pA1, pB0, pB1; float mnA, mnB, alA, alB; bf16x8 pa0, pa1, pa2, pa3; const int NT = seq / KVBLK;
  constexpr int SE = 0, SO = SDEPTH - 1;
  SLOAD(SE, 0); asm volatile("s_waitcnt vmcnt(0)" ::: "memory"); SWRITE(0, SE); __syncthreads();
  qkt(pA0, pA1, K_lds, qr, r32, hi); partialSM(pA0, pA1, m_reg, mnA, alA);
  SLOAD(SO, KVBLK); if constexpr (SDEPTH == 2) { if (2 < NT) SLOAD(SE, 2 * KVBLK); }
  SWAIT(); SWRITE(1, SO); __syncthreads();
  for (int j = 1; j + 1 < NT; j += 2) {
    SBAR(); qkt(pB0, pB1, (bf16*)((char*)K_lds + SHM_K), qr, r32, hi);
    finishSM(pA0, pA1, alA, l_reg, pa0, pa1, pa2, pa3); SBAR();
    SLOAD(SO, (j + SDEPTH) * KVBLK); SBAR();
    pv_d0(o, vb0, pa0, pa1, pa2, pa3); partialSM(pB0, pB1, m_reg, mnB, alB);
    __syncthreads(); SWAIT(); SWRITE(0, SE);
    RESC(alB); __syncthreads();
    SBAR(); qkt(pA0, pA1, K_lds, qr, r32, hi);
    finishSM(pB0, pB1, alB, l_reg, pa0, pa1, pa2, pa3); SBAR();
    if (SDEPTH == 1 || j + 3 < NT) SLOAD(SE, (j + 1 + SDEPTH) * KVBLK); SBAR();
    pv_d0(o, vb0 + (int)SHM_V, pa0, pa1, pa2, pa3); partialSM(pA0, pA1, m_reg, mnA, alA);
    __syncthreads(); SWAIT(); SWRITE(1, SO);
    RESC(alA); __syncthreads();
  }
  SBAR(); qkt(pB0, pB1, (bf16*)((char*)K_lds + SHM_K), qr, r32, hi);
  finishSM(pA0, pA1, alA, l_reg, pa0, pa1, pa2, pa3); SBAR();
  pv_d0(o, vb0, pa0, pa1, pa2, pa3); partialSM(pB0, pB1, m_reg, mnB, alB);
  __syncthreads(); RESC(alB);
  finishSM(pB0, pB1, alB, l_reg, pa0, pa1, pa2, pa3); SBAR();
  pv_d0(o, vb0 + (int)SHM_V, pa0, pa1, pa2, pa3);
  if (hi == 0) li_l[r32] = l_reg; asm volatile("s_waitcnt lgkmcnt(0)" ::: "memory");
  float rli[16];
#pragma unroll
  for (int r = 0; r < 16; ++r) rli[r] = __builtin_amdgcn_rcpf(li_l[crow(r, hi)]);
  unsigned short* Ow = Ob + (long)(wid * QBLK) * LDO;
#pragma unroll
  for (int r = 0; r < 16; ++r) { int orow = crow(r, hi);
    for (int d0 = 0; d0 < 4; ++d0) Ow[(long)orow * LDO + d0 * 32 + r32] = (unsigned short)(cvtpk(o[d0][r] * rli[r], 0.f) & 0xffffu); }
#undef SLOAD
#undef SWRITE
#undef SWAIT
#undef RESC
}

#undef KSWZ
#undef SBAR
}
constexpr int DM = 1024, NBATCH = 4, SEQ = 4096, CTXL = 256, TPB = CTXL + SEQ  , NT = NBATCH * TPB  ;
constexpr int NLAYER = 4, FFN = 3584, NEXP = 8;
constexpr float DN_ALPHA = 1.6817928305074290f;
constexpr float LN_EPS = 1e-5f, RMS_EPS = 1e-6f;
constexpr int MOE_MAXT = 144;
constexpr int NWAVES = 8;

constexpr size_t MiB = 1u << 20;
constexpr size_t WS_CTL = 0, CTL_ZERO_BYTES = 1 * MiB;
constexpr size_t WS_ADA = 1 * MiB;
constexpr size_t WS_TI = 2 * MiB;
constexpr size_t WS_TW = 2 * MiB + 512 * 1024;
constexpr size_t WS_POS = 3 * MiB;
constexpr size_t WS_BB = 3 * MiB + 512 * 1024;
constexpr size_t WS_PS = 4 * MiB;
constexpr size_t WS_X = 10 * MiB;
constexpr size_t WS_H = 78 * MiB;
constexpr size_t WS_W = 112 * MiB;
constexpr size_t WS_WM = 192 * MiB;
constexpr size_t WS_ACT = 360 * MiB;
constexpr size_t WS_END = 768 * MiB;
constexpr size_t W_L0_QKV = WS_W, W_L0_WO = W_L0_QKV + 3 * MiB, W_L0_GU = W_L0_WO + 2 * MiB, W_L0_DN = W_L0_GU + 14 * MiB;
constexpr size_t W_L1_IN = W_L0_DN + 7 * MiB, W_L1_OUT = W_L1_IN + 8 * MiB;
constexpr size_t W_L2_IN = W_L1_OUT + 4 * MiB, W_L2_WO = W_L2_IN + 12 * MiB, W_L2_GU = W_L2_WO + 4 * MiB, W_L2_DN = W_L2_GU + 14 * MiB;
constexpr size_t W_L3_QKV = W_L2_DN + 7 * MiB, W_L3_WO = W_L3_QKV + 3 * MiB;
static_assert(W_L3_WO + 2 * MiB <= WS_WM, "weights map");
constexpr size_t WM_GU = WS_WM, WM_DN = WS_WM + 112 * MiB;
constexpr size_t A_QKV = WS_ACT, A_O = WS_ACT + 52 * MiB;
constexpr size_t A_HID = WS_ACT;
constexpr size_t A_Z = WS_ACT, A_UV = WS_ACT + 136 * MiB;
constexpr size_t A_HP = WS_ACT, A_HM = WS_ACT + 72 * MiB, A_OM = WS_ACT + 324 * MiB;
constexpr size_t A_RQ = WS_ACT, A_OF = WS_ACT + 204 * MiB, A_OB = WS_ACT + 272 * MiB, A_FIN = WS_ACT + 340 * MiB;
static_assert(A_OM + 72 * MiB <= WS_END && A_FIN + 68 * MiB <= WS_END, "act map");
constexpr int CW_TMO = 0;
constexpr int CW_BAR = 4096;
constexpr int CW_CNT = 16384;

constexpr int LDS_BYTES = 163840;
constexpr int MISC_OFF = LDS_BYTES - 512;
constexpr int LDS_MOE_OFF = LDS_BYTES - 448;

#define GAS __attribute__((address_space(1)))
#define LAS __attribute__((address_space(3)))
typedef unsigned short bf16;
typedef unsigned v4u __attribute__((ext_vector_type(4)));
typedef unsigned v2u __attribute__((ext_vector_type(2)));
typedef float f32x4 __attribute__((ext_vector_type(4)));
typedef float f32x2 __attribute__((ext_vector_type(2)));
typedef short bf16x8 __attribute__((ext_vector_type(8)));
typedef short s16x4 __attribute__((ext_vector_type(4)));
typedef GAS unsigned gu32;
#define RLX_AGENT __ATOMIC_RELAXED, __HIP_MEMORY_SCOPE_AGENT
#define LDS_WAIT() asm volatile("s_waitcnt lgkmcnt(0)" ::: "memory")
#define VM_WAIT() asm volatile("s_waitcnt vmcnt(0)" ::: "memory")
__device__ __forceinline__ unsigned f2bf(float f) { unsigned u = __builtin_bit_cast(unsigned, f); return (u + 0x7fffu + ((u >> 16) & 1u)) >> 16; }
__device__ __forceinline__ unsigned pk2(float lo, float hi) { return f2bf(lo) | (f2bf(hi) << 16); }
__device__ __forceinline__ float bf2f(unsigned short b) { return __builtin_bit_cast(float, (unsigned)b << 16); }
__device__ __forceinline__ float bflo(unsigned w) { return __builtin_bit_cast(float, w << 16); }
__device__ __forceinline__ float bfhi(unsigned w) { return __builtin_bit_cast(float, w & 0xffff0000u); }
#define XB_TMO      128
#define XB_XCNT(j)  (256  + 64 * (j))
#define XB_XSUB(j)  (1280 + 64 * (j))
#define XB_XGEN(j)  (2304 + 64 * (j))
#define XB_TOP      3328
#define XB_TOPGEN   3392
#define XCD_BAR_WORDS 3456
#define XB_SPIN_CAP (1u << 18)

__device__ __forceinline__ unsigned xb_ld(unsigned* p)              { return __hip_atomic_load(p, __ATOMIC_RELAXED, __HIP_MEMORY_SCOPE_AGENT); }
__device__ __forceinline__ unsigned xb_add(unsigned* p, unsigned v) { return __hip_atomic_fetch_add(p, v, __ATOMIC_RELAXED, __HIP_MEMORY_SCOPE_AGENT); }
__device__ __forceinline__ unsigned xb_xcc_id() { return (unsigned)__builtin_amdgcn_s_getreg((3 << 11) | 20) & 0xFu; }
#define XB_SPIN(cond, bar) do { unsigned _sp = 0; while (cond) { __builtin_amdgcn_s_sleep(1); \
    if ((++_sp & 255u) == 0u) { if (xb_ld(&(bar)[XB_TMO])) break; if (_sp > XB_SPIN_CAP) { atomicAdd(&(bar)[XB_TMO], 1u); break; } } } } while (0)

struct XcdBarrier {
    unsigned* bar; unsigned x;
    volatile LAS unsigned* st;
};

__device__ __forceinline__ XcdBarrier xcd_barrier_post(unsigned* bar, volatile LAS unsigned* st) {
    XcdBarrier b; b.bar = bar; b.x = xb_xcc_id(); b.st = st;
    if (threadIdx.x == 0) (void)xb_add(&bar[XB_XCNT(b.x)], 1u);
    return b;
}
__device__ __forceinline__ void xcd_barrier_complete(unsigned* bar, unsigned x, unsigned& nloc, unsigned& nx) {
    const unsigned G = gridDim.x * gridDim.y * gridDim.z;
    unsigned sum, cnt, mine, sp = 0u;
    for (;;) {
        sum = 0u; cnt = 0u; mine = 0u;
#pragma unroll
        for (unsigned j = 0; j < 16; ++j) { const unsigned c = xb_ld(&bar[XB_XCNT(j)]); sum += c; cnt += (c > 0u) ? 1u : 0u; mine = (j == x) ? c : mine; }
        if (sum == G) break;
        __builtin_amdgcn_s_sleep(1);
        if ((++sp & 255u) == 0u) { if (xb_ld(&bar[XB_TMO])) break; if (sp > XB_SPIN_CAP) { atomicAdd(&bar[XB_TMO], 1u); break; } }
    }
    nloc = mine > 0u ? mine : 1u; nx = cnt > 0u ? cnt : 1u;
}

__device__ __forceinline__ void xcd_barrier(const XcdBarrier& b) {
    asm volatile("s_waitcnt vmcnt(0)" ::: "memory");
    __syncthreads();
    if (threadIdx.x == 0) {
        unsigned* bar = b.bar;
        __builtin_amdgcn_s_waitcnt(0);
        unsigned nloc = b.st[0], nx = b.st[1];
        if (nloc == 0u) { xcd_barrier_complete(bar, b.x, nloc, nx); b.st[0] = nloc; b.st[1] = nx; }
        const unsigned old = xb_add(&bar[XB_XSUB(b.x)], 1u);
        const unsigned gen = old / nloc;
        if (old + 1u == (gen + 1u) * nloc) {
            __builtin_amdgcn_fence(__ATOMIC_RELEASE, "agent");
            asm volatile("s_waitcnt vmcnt(0)" ::: "memory");
            const unsigned og = xb_add(&bar[XB_TOP], 1u);
            const unsigned tg = og / nx;
            if (og + 1u == (tg + 1u) * nx) xb_add(&bar[XB_TOPGEN], 1u);
            else XB_SPIN(xb_ld(&bar[XB_TOPGEN]) == tg, bar);
            __builtin_amdgcn_fence(__ATOMIC_ACQUIRE, "agent");
            xb_add(&bar[XB_XGEN(b.x)], 1u);
            asm volatile("s_waitcnt vmcnt(0)" ::: "memory");
        } else {
            XB_SPIN(xb_ld(&bar[XB_XGEN(b.x)]) == gen, bar);
            __builtin_amdgcn_fence(__ATOMIC_ACQUIRE, "agent");
            asm volatile("s_waitcnt vmcnt(0)" ::: "memory");
        }
    }
    __syncthreads();
}
struct Args { const float* in[57]; float* out; unsigned char* ws; int ph_lo, ph_hi; };
struct Frame {
    LAS unsigned char* lds;
    unsigned char* ws;
    gu32* ctl;
    int tid, lane, wave, vcu, G;
};
__device__ __forceinline__ float wave_sum(float v) {
#pragma unroll
    for (int o = 1; o < 64; o <<= 1) v += __shfl_xor(v, o);
    return v;
}
__device__ __forceinline__ s16x4 ds_tr(const LAS unsigned char* p) { typedef short v4i16_t __attribute__((ext_vector_type(4))); return __builtin_bit_cast(s16x4, __builtin_amdgcn_ds_read_tr16_b64_v4i16((LAS v4i16_t*)p)); }
__device__ __forceinline__ bf16x8 cat44(s16x4 a, s16x4 b) { return (bf16x8){a[0], a[1], a[2], a[3], b[0], b[1], b[2], b[3]}; }
__device__ __forceinline__ float ada_at(const Frame& F, int L, int cidx, int chunk, int col) { return ((const float*)(F.ws + WS_ADA))[((size_t)(L * 5 + cidx) * 6 + chunk) * 1024 + col]; }
__device__ __forceinline__ int row_cidx(int r) { const int b = r / TPB, w = r - b * TPB; return w < CTXL ? 4 : b; }

__device__ __forceinline__ void transpose_item(const float* W, int K, int N, bf16* WT, int drow0, LAS float* scr, int k0, int n0, int lane) {
#pragma unroll 8
    for (int i = 0; i < 32; ++i) { const int kk = 2 * i + (lane >> 5); scr[kk * 33 + (lane & 31)] = W[(size_t)(k0 + kk) * N + n0 + (lane & 31)]; }
    LDS_WAIT(); asm volatile("" ::: "memory");
    const int c = lane & 7;
#pragma unroll
    for (int j = 0; j < 4; ++j) { const int n = (lane >> 3) + 8 * j; const LAS float* s = scr + (8 * c) * 33 + n;
        v4u o; o.x = pk2(s[0 * 33], s[1 * 33]); o.y = pk2(s[2 * 33], s[3 * 33]); o.z = pk2(s[4 * 33], s[5 * 33]); o.w = pk2(s[6 * 33], s[7 * 33]);
        *(GAS v4u*)(WT + (size_t)(drow0 + n) * K + k0 + 8 * c) = o; }
    LDS_WAIT(); asm volatile("" ::: "memory");
}
__device__ __forceinline__ void convert_group(Frame& F, const float* src, bf16* dst, int K, int N, int nmat, int mode, int& it0, int gw, int NGW) {
    LAS float* scr = (LAS float*)(F.lds + F.wave * 16384);
    const int nblk = N / 32, ipm = (K / 64) * nblk, total = nmat * ipm;
    int first = (it0 <= gw) ? gw - it0 : (NGW - ((it0 - gw) % NGW)) % NGW;
    for (int l = first; l < total; l += NGW) {
        const int mat = l / ipm, r = l - mat * ipm, kb = r / nblk, nb = r - kb * nblk, n0 = 32 * nb;
        int drow0 = n0;
        if (mode) { const int half = N / 2; const int j = n0 < half ? n0 : n0 - half; drow0 = 256 * (j >> 7) + (j & 127) + (n0 < half ? 0 : 128); }
        transpose_item(src + (size_t)mat * K * N, K, N, dst + (size_t)mat * K * N, drow0, scr, 64 * kb, n0, F.lane);
    }
    it0 += total;
}
__device__ __forceinline__ void ada_phase(Frame& F, const Args& args) {
    LAS float* sc = (LAS float*)(F.lds + 65536);
    LAS float* red = (LAS float*)(F.lds + 65536 + 20480);
    for (int i = F.tid; i < 5 * 1024; i += 512) { const float v = i < 4096 ? args.in[1][i] : args.in[3][i - 4096]; sc[i] = v / (1.0f + __expf(-v)); }
    __syncthreads();
    for (int u = F.vcu; u < NLAYER * 96; u += F.G) {
        const int L = u / 96, cg = u - L * 96, col = cg * 64 + F.lane;
        const float* w = (L == 0 ? args.in[4] : L == 1 ? args.in[16] : L == 2 ? args.in[33] : args.in[44]);
        const float* bsrc = (L == 0 ? args.in[5] : L == 1 ? args.in[17] : L == 2 ? args.in[34] : args.in[45]);
        float acc[5] = {0.f, 0.f, 0.f, 0.f, 0.f};
        const int k0 = F.wave * 128;
#pragma unroll 16
        for (int k = 0; k < 128; ++k) { const float wv = w[(size_t)(k0 + k) * 6144 + col];
#pragma unroll
            for (int ci = 0; ci < 5; ++ci) acc[ci] += sc[ci * 1024 + k0 + k] * wv; }
#pragma unroll
        for (int ci = 0; ci < 5; ++ci) red[(F.wave * 5 + ci) * 64 + F.lane] = acc[ci];
        __syncthreads();
        if (F.tid < 320) { const int ci = F.tid >> 6, l = F.tid & 63; float s = 0.f;
#pragma unroll
            for (int wv = 0; wv < 8; ++wv) s += red[(wv * 5 + ci) * 64 + l];
            ((float*)(F.ws + WS_ADA))[(size_t)(L * 5 + ci) * 6144 + cg * 64 + l] = s + bsrc[cg * 64 + l]; }
        __syncthreads();
    }
}
__device__ __forceinline__ void convert_set_a(Frame& F, const Args& args) {
    const int gw = F.vcu * NWAVES + F.wave, NGW = F.G * NWAVES; int it0 = 0; unsigned char* ws = F.ws;
    convert_group(F, args.in[10], (bf16*)(ws + W_L0_QKV), 1024, 1536, 1, 0, it0, gw, NGW);
    convert_group(F, args.in[13], (bf16*)(ws + W_L0_WO), 1024, 1024, 1, 0, it0, gw, NGW);
    convert_group(F, args.in[14], (bf16*)(ws + W_L0_GU), 1024, 7168, 1, 1, it0, gw, NGW);
    convert_group(F, args.in[15], (bf16*)(ws + W_L0_DN), 3584, 1024, 1, 0, it0, gw, NGW);
    convert_group(F, args.in[22], (bf16*)(ws + W_L1_IN), 1024, 4096, 1, 0, it0, gw, NGW);
    convert_group(F, args.in[28], (bf16*)(ws + W_L1_OUT), 2048, 1024, 1, 0, it0, gw, NGW);
    convert_group(F, args.in[39], (bf16*)(ws + W_L2_IN), 1024, 6144, 1, 0, it0, gw, NGW);
    convert_group(F, args.in[41], (bf16*)(ws + W_L2_WO), 2048, 1024, 1, 0, it0, gw, NGW);
    convert_group(F, args.in[42], (bf16*)(ws + W_L2_GU), 1024, 7168, 1, 1, it0, gw, NGW);
    convert_group(F, args.in[43], (bf16*)(ws + W_L2_DN), 3584, 1024, 1, 0, it0, gw, NGW);
    convert_group(F, args.in[50], (bf16*)(ws + W_L3_QKV), 1024, 1536, 1, 0, it0, gw, NGW);
    convert_group(F, args.in[53], (bf16*)(ws + W_L3_WO), 1024, 1024, 1, 0, it0, gw, NGW);
    convert_group(F, args.in[31], (bf16*)(ws + WM_GU), 1024, 7168, 8, 1, it0, gw, NGW);
    convert_group(F, args.in[32], (bf16*)(ws + WM_DN), 3584, 1024, 8, 0, it0, gw, NGW);
}
__device__ __forceinline__ void convert_set_b(Frame& F, const Args& args) {
    const int gw = F.vcu * NWAVES + F.wave, NGW = F.G * NWAVES; int it0 = 0; unsigned char* ws = F.ws;
    convert_group(F, args.in[55], (bf16*)(ws + WM_GU), 1024, 7168, 8, 1, it0, gw, NGW);
    convert_group(F, args.in[56], (bf16*)(ws + WM_DN), 3584, 1024, 8, 0, it0, gw, NGW);
}

struct RowP { int mode, L, moe; const float* g; const float* b; const float* router; };
__device__ __forceinline__ void row_phase(Frame& F, const Args& args, const RowP P) {
    float* X = (float*)(F.ws + WS_X); bf16* H = (bf16*)(F.ws + WS_H);
    LAS unsigned* lcnt = (LAS unsigned*)(F.lds + 1024);
    const bool route = (P.mode == 1 && P.moe);
    if (route) { if (F.tid < 8) lcnt[F.tid] = 0u; __syncthreads(); }
    const int gw = F.vcu * NWAVES + F.wave, NGW = F.G * NWAVES, lane = F.lane;
    const bool last = (P.mode == 2 && P.L == NLAYER - 1);
    f32x4 gv[4], bv[4];
    if (P.mode != 0) {
#pragma unroll
        for (int j = 0; j < 4; ++j) { gv[j] = ((const f32x4*)P.g)[lane + 64 * j]; bv[j] = ((const f32x4*)P.b)[lane + 64 * j]; }
    }
    for (int r = gw; r < NT; r += NGW) {
        const int b = r / TPB, w = r - b * TPB, cidx = w < CTXL ? 4 : b;
        f32x4 v[4];
        if (P.mode == 0) {
            const float* src = w < CTXL ? args.in[2] + ((size_t)b * CTXL + w) * DM : args.in[0] + ((size_t)b * SEQ + (w - CTXL)) * DM;
#pragma unroll
            for (int j = 0; j < 4; ++j) v[j] = ((const f32x4*)src)[lane + 64 * j];
        } else {
            const f32x4* xr = (const f32x4*)(X + (size_t)r * DM);
#pragma unroll
            for (int j = 0; j < 4; ++j) v[j] = xr[lane + 64 * j];
            if (P.mode == 2 && P.moe) {
                const int* pos = (const int*)(F.ws + WS_POS) + 2 * r; const float* tw = (const float*)(F.ws + WS_TW) + 2 * r;
                const int p1 = pos[0], p2 = pos[1]; const float w1 = tw[0], w2 = tw[1];
                const bf16* OM = (const bf16*)(F.ws + A_OM);
                const v2u* o1 = (const v2u*)(OM + (size_t)p1 * DM); const v2u* o2 = (const v2u*)(OM + (size_t)p2 * DM);
                const f32x4* g2 = (const f32x4*)((const float*)(F.ws + WS_ADA) + ((size_t)(P.L * 5 + cidx) * 6 + 5) * 1024);
#pragma unroll
                for (int j = 0; j < 4; ++j) { const v2u a = o1[lane + 64 * j], c = o2[lane + 64 * j]; const f32x4 gg = g2[lane + 64 * j];
                    f32x4 f; f[0] = w1 * bflo(a.x) + w2 * bflo(c.x); f[1] = w1 * bfhi(a.x) + w2 * bfhi(c.x); f[2] = w1 * bflo(a.y) + w2 * bflo(c.y); f[3] = w1 * bfhi(a.y) + w2 * bfhi(c.y);
                    v[j] = v[j] * DN_ALPHA + gg * f; }
            }
            float s = 0.f;
#pragma unroll
            for (int j = 0; j < 4; ++j) s += (v[j][0] + v[j][1]) + (v[j][2] + v[j][3]);
            const float mean = wave_sum(s) * (1.f / DM); float s2 = 0.f;
#pragma unroll
            for (int j = 0; j < 4; ++j) { v[j] = v[j] - mean; s2 += (v[j][0] * v[j][0] + v[j][1] * v[j][1]) + (v[j][2] * v[j][2] + v[j][3] * v[j][3]); }
            const float rstd = 1.f / sqrtf(wave_sum(s2) * (1.f / DM) + LN_EPS);
#pragma unroll
            for (int j = 0; j < 4; ++j) v[j] = v[j] * rstd * gv[j] + bv[j];
        }
        if (last) {
            if (w >= CTXL) { f32x4* o = (f32x4*)(args.out + ((size_t)b * SEQ + (w - CTXL)) * DM);
#pragma unroll
                for (int j = 0; j < 4; ++j) o[lane + 64 * j] = v[j]; }
            continue;
        }
        { f32x4* xo = (f32x4*)(X + (size_t)r * DM);
#pragma unroll
          for (int j = 0; j < 4; ++j) xo[lane + 64 * j] = v[j]; }
        const int ML = P.mode == 1 ? P.L : (P.mode == 0 ? 0 : P.L + 1), ch = P.mode == 1 ? 3 : 0;
        const f32x4* sh = (const f32x4*)((const float*)(F.ws + WS_ADA) + ((size_t)(ML * 5 + cidx) * 6 + ch) * 1024);
        const f32x4* scl = sh + 256;
        f32x4 h[4];
#pragma unroll
        for (int j = 0; j < 4; ++j) h[j] = v[j] * (scl[lane + 64 * j] + 1.0f) + sh[lane + 64 * j];
        { v2u* ho = (v2u*)(H + (size_t)r * DM);
#pragma unroll
          for (int j = 0; j < 4; ++j) { v2u o; o.x = pk2(h[j][0], h[j][1]); o.y = pk2(h[j][2], h[j][3]); ho[lane + 64 * j] = o; } }
        if (route) {
            float lg[8] = {0.f, 0.f, 0.f, 0.f, 0.f, 0.f, 0.f, 0.f};
#pragma unroll
            for (int j = 0; j < 4; ++j)
#pragma unroll
                for (int i = 0; i < 4; ++i) { const f32x4* rw = (const f32x4*)(P.router + (size_t)(4 * lane + 256 * j + i) * 8); const f32x4 r0 = rw[0], r1 = rw[1]; const float hv = h[j][i];
                    lg[0] += hv * r0[0]; lg[1] += hv * r0[1]; lg[2] += hv * r0[2]; lg[3] += hv * r0[3]; lg[4] += hv * r1[0]; lg[5] += hv * r1[1]; lg[6] += hv * r1[2]; lg[7] += hv * r1[3]; }
#pragma unroll
            for (int e = 0; e < 8; ++e) lg[e] = wave_sum(lg[e]);
            int e1 = 0; float l1 = lg[0];
#pragma unroll
            for (int e = 1; e < 8; ++e) if (lg[e] > l1) { l1 = lg[e]; e1 = e; }
            int e2 = -1; float l2 = -3.0e38f;
#pragma unroll
            for (int e = 0; e < 8; ++e) if (e != e1 && lg[e] > l2) { l2 = lg[e]; e2 = e; }
            if (e2 < 0) e2 = (e1 + 1) & 7;
            if (lane == 0) {
                const float w2 = 1.0f / (1.0f + __expf(l1 - l2)), w1 = 1.0f - w2;
                const unsigned lr1 = __hip_atomic_fetch_add(&lcnt[e1], 1u, __ATOMIC_RELAXED, __HIP_MEMORY_SCOPE_WORKGROUP), lr2 = __hip_atomic_fetch_add(&lcnt[e2], 1u, __ATOMIC_RELAXED, __HIP_MEMORY_SCOPE_WORKGROUP);
                v4u ti; ti.x = (unsigned)e1 | ((unsigned)e2 << 8) | ((unsigned)blockIdx.x << 16); ti.y = lr1; ti.z = lr2; ti.w = 0u;
                ((v4u*)(F.ws + WS_TI))[r] = ti; ((f32x2*)(F.ws + WS_TW))[r] = (f32x2){w1, w2};
            }
        }
    }
    if (route) {
        __syncthreads();
        if (F.tid < 8) { const unsigned base = __hip_atomic_fetch_add(F.ctl + CW_CNT + 64 * P.L + F.tid, lcnt[F.tid], RLX_AGENT);
            ((unsigned*)(F.ws + WS_BB))[blockIdx.x * 8 + F.tid] = base; }
    }
}

__device__ __forceinline__ void moe_layout(Frame& F, int L) {
    LAS unsigned* T = (LAS unsigned*)(F.lds + LDS_MOE_OFF);
    __syncthreads();
    if (F.tid == 0) {
        unsigned o = 0; LAS unsigned char* texp = (LAS unsigned char*)(T + 20);
        for (int e = 0; e < 8; ++e) { const unsigned c = __hip_atomic_load(F.ctl + CW_CNT + 64 * L + e, RLX_AGENT); const unsigned nt = (c + 255u) >> 8;
            T[1 + e] = o * 256u; T[9 + e] = c; for (unsigned t = 0; t < nt && o + t < (unsigned)MOE_MAXT; ++t) texp[o + t] = (unsigned char)e; o += nt; }
        T[0] = o < (unsigned)MOE_MAXT ? o : (unsigned)MOE_MAXT;
    }
    __syncthreads();
}
__device__ __forceinline__ void moe_scatter(Frame& F, int L) {
    moe_layout(F, L);
    const LAS unsigned* T = (const LAS unsigned*)(F.lds + LDS_MOE_OFF);
    const int gw = F.vcu * NWAVES + F.wave, NGW = F.G * NWAVES, lane = F.lane;
    const bf16* H = (const bf16*)(F.ws + WS_H); bf16* HP = (bf16*)(F.ws + A_HP);
    for (int r = gw; r < NT; r += NGW) {
        const v4u ti = ((const v4u*)(F.ws + WS_TI))[r];
        const int e1 = ti.x & 0xff, e2 = (ti.x >> 8) & 0xff, blk = ti.x >> 16;
        const unsigned* bb = (const unsigned*)(F.ws + WS_BB) + blk * 8;
        const int p1 = (int)(T[1 + e1] + bb[e1] + ti.y), p2 = (int)(T[1 + e2] + bb[e2] + ti.z);
        const v4u* src = (const v4u*)(H + (size_t)r * DM);
        const v4u a = src[lane], c = src[lane + 64];
        v4u* d1 = (v4u*)(HP + (size_t)p1 * DM); v4u* d2 = (v4u*)(HP + (size_t)p2 * DM);
        d1[lane] = a; d1[lane + 64] = c; d2[lane] = a; d2[lane + 64] = c;
        if (lane == 0) { int* pos = (int*)(F.ws + WS_POS) + 2 * r; pos[0] = p1; pos[1] = p2; }
    }
    for (int e = 0; e < 8; ++e) {
        const unsigned c = T[9 + e], o = T[1 + e], end = o + ((c + 255u) & ~255u);
        for (unsigned p = o + c + gw; p < end; p += NGW) { v4u* d = (v4u*)(HP + (size_t)p * DM); const v4u z = {0u, 0u, 0u, 0u}; d[lane] = z; d[lane + 64] = z; }
    }
}
__device__ __forceinline__ void rope_table(Frame& F, LAS f32x2* tab, int nf) {
    for (int i = F.tid; i < 64 * nf; i += 512) { const int pos = i / nf, k = i - pos * nf;
        const float inv = __builtin_amdgcn_exp2f(-(float)k / (float)nf * 13.287712379549449f);
        const float ang = (float)pos * inv, rev = ang * 0.15915494309189535f, fr = rev - floorf(rev);
        tab[i] = (f32x2){__builtin_amdgcn_cosf(fr), __builtin_amdgcn_sinf(fr)}; }
    __syncthreads();
}
__device__ __forceinline__ void attn_normrope(Frame& F, const float* qn, const float* kn) {
    LAS f32x2* tab = (LAS f32x2*)F.lds; rope_table(F, tab, 32);
    bf16* QKV = (bf16*)(F.ws + A_QKV);
    const int gw = F.vcu * NWAVES + F.wave, NGW = F.G * NWAVES, lane = F.lane;
    const int half = lane >> 5, li = lane & 31, d0 = half * 64 + li;
    const float gq0 = qn[d0], gq1 = qn[d0 + 32], gk0 = kn[d0], gk1 = kn[d0 + 32];
    for (int it = gw; it < NT * 10; it += NGW) {
        const int r = it / 10, hs = it - r * 10;
        const int b = r / TPB, w = r - b * TPB;
        bf16* p = QKV + (size_t)r * 1536 + hs * 128 + d0;
        const float a = bf2f(p[0]), c = bf2f(p[32]);
        const float ss = wave_sum(a * a + c * c);
        const float rinv = 1.0f / sqrtf(ss * (1.0f / 128.0f) + RMS_EPS);
        float xa = a * rinv * (hs < 8 ? gq0 : gk0), xb = c * rinv * (hs < 8 ? gq1 : gk1);
        if (w >= CTXL) { const int t = w - CTXL, pos = half ? (t & 63) : (t >> 6); const f32x2 cs = tab[pos * 32 + li];
            const float ra = xa * cs.x - xb * cs.y, rb = xb * cs.x + xa * cs.y; xa = ra; xb = rb; }
        p[0] = (bf16)f2bf(xa); p[32] = (bf16)f2bf(xb);
    }
}
__device__ __forceinline__ void attn_units(Frame& F, char* lds_generic) {
    const att::bf16* QKV = (const att::bf16*)(F.ws + A_QKV); unsigned short* O = (unsigned short*)(F.ws + A_O);
    for (int L = F.vcu; L < 544; L += F.G) {
        if (L < 512) { const int qb = L & 15, g = (L >> 4) & 3, kvh = (L >> 6) & 1, b = L >> 7, h = kvh * 4 + g;
            const size_t rowq = (size_t)b * TPB + CTXL + qb * 256, rowk = (size_t)b * TPB;
            att::attn_dense_body<1536, 1536, 1024>(QKV + rowq * 1536 + h * 128, QKV + rowk * 1536 + 1024 + kvh * 128, QKV + rowk * 1536 + 1280 + kvh * 128, O + rowq * 1024 + h * 128, TPB, lds_generic);
        } else { const int u = L - 512, h = u & 7, b = u >> 3, kvh = h >> 2; const size_t rowk = (size_t)b * TPB;
            att::attn_dense_body<1536, 1536, 1024>(QKV + rowk * 1536 + h * 128, QKV + rowk * 1536 + 1024 + kvh * 128, QKV + rowk * 1536 + 1280 + kvh * 128, O + rowk * 1024 + h * 128, CTXL, lds_generic);
        }
        __syncthreads();
    }
}

__device__ __forceinline__ void cmlp_mix(Frame& F, const float* vng, const float* vnb, const float* w_s, const float* b_s) {
    constexpr int WP = 272, VP = 272;
    LAS unsigned char* WS_ = F.lds;
    LAS unsigned char* VT = F.lds + 128 * WP;
    LAS f32x2* MR = (LAS f32x2*)(F.lds + 128 * WP + 256 * VP);
    const bf16* Z = (const bf16*)(F.ws + A_Z); bf16* UV = (bf16*)(F.ws + A_UV);
    const int tid = F.tid, lane = F.lane, w = F.wave, fr = lane & 15, fq = lane >> 4;
    for (int u = F.vcu; u < 136 * 8; u += F.G) {
        const int n = u >> 3, g = u & 7, row0 = n * 128;
        if (tid < 128) { const f32x2* ps = (const f32x2*)(F.ws + WS_PS) + (size_t)(row0 + tid) * 32; float s = 0.f, q = 0.f;
#pragma unroll 8
            for (int i = 0; i < 32; ++i) { const f32x2 t = ps[i]; s += t.x; q += t.y; }
            const float mean = s * (1.0f / 2048.0f), var = q * (1.0f / 2048.0f) - mean * mean;
            MR[tid] = (f32x2){mean, 1.0f / sqrtf(fmaxf(var, 0.f) + LN_EPS)}; }
#pragma unroll
        for (int i = 0; i < 8; ++i) { const int id = tid + 512 * i, p = id >> 5, q4 = (id & 31) * 4;
            const f32x4 wv = *(const f32x4*)(w_s + ((size_t)g * 128 + p) * 128 + q4);
            v2u o; o.x = pk2(wv[0], wv[1]); o.y = pk2(wv[2], wv[3]); *(LAS v2u*)(WS_ + p * WP + q4 * 2) = o; }
        __syncthreads();
        { const int ch = tid & 31, c0 = ch * 8; f32x4 ga0 = *(const f32x4*)(vng + g * 256 + c0), ga1 = *(const f32x4*)(vng + g * 256 + c0 + 4), be0 = *(const f32x4*)(vnb + g * 256 + c0), be1 = *(const f32x4*)(vnb + g * 256 + c0 + 4);
#pragma unroll
          for (int i = 0; i < 8; ++i) { const int q = (tid >> 5) + 16 * i;
              const v4u zv = *(const v4u*)(Z + (size_t)(row0 + q) * 4096 + 2048 + g * 256 + c0); const f32x2 mr = MR[q];
              float x[8] = {bflo(zv.x), bfhi(zv.x), bflo(zv.y), bfhi(zv.y), bflo(zv.z), bfhi(zv.z), bflo(zv.w), bfhi(zv.w)};
#pragma unroll
              for (int k = 0; k < 8; ++k) { const float gk = k < 4 ? ga0[k & 3] : ga1[k & 3], bk = k < 4 ? be0[k & 3] : be1[k & 3];
                  *(LAS unsigned short*)(VT + (c0 + k) * VP + q * 2) = (unsigned short)f2bf((x[k] - mr.x) * mr.y * gk + bk); } } }
        __syncthreads();
        pg8::f32x4 acc[8][2];
#pragma unroll
        for (int m = 0; m < 8; ++m) { acc[m][0] = (pg8::f32x4){0.f, 0.f, 0.f, 0.f}; acc[m][1] = (pg8::f32x4){0.f, 0.f, 0.f, 0.f}; }
#pragma unroll
        for (int ks = 0; ks < 4; ++ks) {
            const bf16x8 b0 = *(const LAS bf16x8*)(VT + (32 * w + fr) * VP + (32 * ks + 8 * fq) * 2), b1 = *(const LAS bf16x8*)(VT + (32 * w + 16 + fr) * VP + (32 * ks + 8 * fq) * 2);
#pragma unroll
            for (int m = 0; m < 8; ++m) { const bf16x8 a = *(const LAS bf16x8*)(WS_ + (16 * m + fr) * WP + (32 * ks + 8 * fq) * 2);
                acc[m][0] = __builtin_amdgcn_mfma_f32_16x16x32_bf16(a, b0, acc[m][0], 0, 0, 0); acc[m][1] = __builtin_amdgcn_mfma_f32_16x16x32_bf16(a, b1, acc[m][1], 0, 0, 0); }
        }
#pragma unroll
        for (int m = 0; m < 8; ++m)
#pragma unroll
            for (int j = 0; j < 4; ++j) { const int p = 16 * m + 4 * fq + j; const float bs = b_s[g * 128 + p];
#pragma unroll
                for (int nn = 0; nn < 2; ++nn) { const int c = 32 * w + 16 * nn + fr; const size_t zr = (size_t)(row0 + p);
                    const float uu = bf2f(Z[zr * 4096 + g * 256 + c]);
                    UV[zr * 2048 + g * 256 + c] = (bf16)f2bf(uu * (acc[m][nn][j] + bs)); } }
        __syncthreads();
    }
}

__device__ __forceinline__ void ret_rope(Frame& F) {
    LAS f32x2* tab = (LAS f32x2*)F.lds; rope_table(F, tab, 64);
    bf16* RQ = (bf16*)(F.ws + A_RQ);
    const int gw = F.vcu * NWAVES + F.wave, NGW = F.G * NWAVES, lane = F.lane;
    for (int it = gw; it < NT * 8; it += NGW) {
        const int r = it >> 3, hs = it & 7, isk = hs >> 2, h = hs & 3;
        const int b = r / TPB, w = r - b * TPB;
        if (w < CTXL && !isk) continue;
        bf16* p = RQ + (size_t)r * 6144 + isk * 1024 + h * 256;
        float a0 = bf2f(p[lane]), b0 = bf2f(p[lane + 64]), a1 = bf2f(p[128 + lane]), b1 = bf2f(p[192 + lane]);
        if (w >= CTXL) { const int t = w - CTXL; const f32x2 c0 = tab[(t >> 6) * 64 + lane], c1 = tab[(t & 63) * 64 + lane];
            const float ra0 = a0 * c0.x - b0 * c0.y, rb0 = b0 * c0.x + a0 * c0.y, ra1 = a1 * c1.x - b1 * c1.y, rb1 = b1 * c1.x + a1 * c1.y; a0 = ra0; b0 = rb0; a1 = ra1; b1 = rb1; }
        const float sc = isk ? 0.0625f : 1.0f;
        p[lane] = (bf16)f2bf(a0 * sc); p[lane + 64] = (bf16)f2bf(b0 * sc); p[128 + lane] = (bf16)f2bf(a1 * sc); p[192 + lane] = (bf16)f2bf(b1 * sc);
    }
}
__device__ __forceinline__ void ret_scan(Frame& F, const float* decay_raw) {
    constexpr int KWP = 528, VVP = 144, STP = 528, PPP = 272;
    constexpr int KW_OFF = 0, VV_OFF = 128 * KWP, ST_OFF = VV_OFF + 128 * VVP, PP_OFF = ST_OFF + 64 * STP;
    static_assert(PP_OFF + 8 * 16 * PPP <= MISC_OFF, "scan LDS map");
    LAS unsigned char* lds = F.lds;
    const bf16* RQ = (const bf16*)(F.ws + A_RQ);
    const int tid = F.tid, lane = F.lane, w = F.wave, fr = lane & 15, fq = lane >> 4, tq = (lane & 15) >> 2, tp = lane & 3;
    for (int c = F.vcu; c < 256; c += F.G) {
        const int dvs = c & 7, dir = (c >> 3) & 1, h = (c >> 4) & 3, b = c >> 6;
        bf16* OUT = (bf16*)(F.ws + (dir ? A_OB : A_OF));
        const float lg2 = -__expf(decay_raw[dir * 4 + h]) * 1.4426950408889634f;
        float sci[4], cri[4];
#pragma unroll
        for (int j = 0; j < 4; ++j) { const int i = 16 * w + 4 * fq + j;
            sci[j] = __builtin_amdgcn_exp2f((dir ? -(float)i : (float)(i - 127)) * lg2);
            cri[j] = __builtin_amdgcn_exp2f((dir ? (float)(128 - i) : (float)(i + 1)) * lg2); }
        const float cd = __builtin_amdgcn_exp2f(128.0f * lg2);
        pg8::f32x4 ST[2][4];
#pragma unroll
        for (int m = 0; m < 2; ++m)
#pragma unroll
            for (int cc = 0; cc < 4; ++cc) ST[m][cc] = (pg8::f32x4){0.f, 0.f, 0.f, 0.f};
        for (int i = tid; i < 64 * STP / 16; i += 512) *(LAS v4u*)(lds + ST_OFF + i * 16) = (v4u){0u, 0u, 0u, 0u};
        __syncthreads();
        for (int s = 0; s < 34; ++s) {
            const int chunk = dir ? (s == 0 ? 1 : (s == 1 ? 0 : 35 - s)) : s;
            const size_t row0 = (size_t)b * TPB + (size_t)chunk * 128;
#pragma unroll
            for (int i = 0; i < 8; ++i) { const int j = (tid >> 5) + 16 * i, ch = tid & 31;
                const v4u kv = *(const v4u*)(RQ + (row0 + j) * 6144 + 1024 + h * 256 + ch * 8);
                const float wj = __builtin_amdgcn_exp2f((dir ? (float)j : (float)(127 - j)) * lg2);
                v4u o; o.x = pk2(bflo(kv.x) * wj, bfhi(kv.x) * wj); o.y = pk2(bflo(kv.y) * wj, bfhi(kv.y) * wj); o.z = pk2(bflo(kv.z) * wj, bfhi(kv.z) * wj); o.w = pk2(bflo(kv.w) * wj, bfhi(kv.w) * wj);
                *(LAS v4u*)(lds + KW_OFF + j * KWP + ch * 16) = o; }
#pragma unroll
            for (int i = 0; i < 2; ++i) { const int j = (tid >> 3) + 64 * i, ch = tid & 7;
                *(LAS v4u*)(lds + VV_OFF + j * VVP + ch * 16) = *(const v4u*)(RQ + (row0 + j) * 6144 + 2048 + h * 512 + dvs * 64 + ch * 8); }
            bf16x8 qf[8];
#pragma unroll
            for (int ks = 0; ks < 8; ++ks) qf[ks] = *(const bf16x8*)(RQ + (row0 + 16 * w + fr) * 6144 + h * 256 + 32 * ks + 8 * fq);
            __syncthreads();
            LAS unsigned char* PP = lds + PP_OFF + w * 16 * PPP;
#pragma unroll
            for (int n = 0; n < 8; ++n) { pg8::f32x4 S = (pg8::f32x4){0.f, 0.f, 0.f, 0.f};
#pragma unroll
                for (int ks = 0; ks < 8; ++ks) { const bf16x8 kf = *(const LAS bf16x8*)(lds + KW_OFF + (16 * n + fr) * KWP + (32 * ks + 8 * fq) * 2);
                    S = __builtin_amdgcn_mfma_f32_16x16x32_bf16(qf[ks], kf, S, 0, 0, 0); }
                const int jj = 16 * n + fr;
#pragma unroll
                for (int j = 0; j < 4; ++j) { const int i = 16 * w + 4 * fq + j; const bool keep = dir ? (jj >= i) : (jj <= i);
                    *(LAS unsigned short*)(PP + (4 * fq + j) * PPP + jj * 2) = (unsigned short)f2bf(keep ? S[j] * sci[j] : 0.f); } }
            LDS_WAIT(); asm volatile("" ::: "memory");
            pg8::f32x4 O1[4], O2[4];
#pragma unroll
            for (int cc = 0; cc < 4; ++cc) { O1[cc] = (pg8::f32x4){0.f, 0.f, 0.f, 0.f}; O2[cc] = (pg8::f32x4){0.f, 0.f, 0.f, 0.f}; }
#pragma unroll
            for (int ks = 0; ks < 4; ++ks) { const bf16x8 pa = *(const LAS bf16x8*)(PP + fr * PPP + (32 * ks + 8 * fq) * 2);
#pragma unroll
                for (int cc = 0; cc < 4; ++cc) { const LAS unsigned char* vp = lds + VV_OFF + (32 * ks + 8 * fq + tq) * VVP + (16 * cc + 4 * tp) * 2;
                    const bf16x8 vb = cat44(ds_tr(vp), ds_tr(vp + 4 * VVP));
                    O1[cc] = __builtin_amdgcn_mfma_f32_16x16x32_bf16(pa, vb, O1[cc], 0, 0, 0); } }
#pragma unroll
            for (int ks = 0; ks < 8; ++ks)
#pragma unroll
                for (int cc = 0; cc < 4; ++cc) { const bf16x8 sb = *(const LAS bf16x8*)(lds + ST_OFF + (16 * cc + fr) * STP + (32 * ks + 8 * fq) * 2);
                    O2[cc] = __builtin_amdgcn_mfma_f32_16x16x32_bf16(qf[ks], sb, O2[cc], 0, 0, 0); }
#pragma unroll
            for (int cc = 0; cc < 4; ++cc)
#pragma unroll
                for (int j = 0; j < 4; ++j) OUT[(row0 + 16 * w + 4 * fq + j) * 2048 + h * 512 + dvs * 64 + 16 * cc + fr] = (bf16)f2bf(O1[cc][j] + cri[j] * O2[cc][j]);
            __syncthreads();
#pragma unroll
            for (int m = 0; m < 2; ++m)
#pragma unroll
                for (int cc = 0; cc < 4; ++cc) ST[m][cc] = ST[m][cc] * cd;
#pragma unroll
            for (int ks = 0; ks < 4; ++ks) { bf16x8 af[2], vb[4];
#pragma unroll
                for (int m = 0; m < 2; ++m) { const LAS unsigned char* kp = lds + KW_OFF + (32 * ks + 8 * fq + tq) * KWP + (32 * w + 16 * m + 4 * tp) * 2; af[m] = cat44(ds_tr(kp), ds_tr(kp + 4 * KWP)); }
#pragma unroll
                for (int cc = 0; cc < 4; ++cc) { const LAS unsigned char* vp = lds + VV_OFF + (32 * ks + 8 * fq + tq) * VVP + (16 * cc + 4 * tp) * 2; vb[cc] = cat44(ds_tr(vp), ds_tr(vp + 4 * VVP)); }
#pragma unroll
                for (int m = 0; m < 2; ++m)
#pragma unroll
                    for (int cc = 0; cc < 4; ++cc) ST[m][cc] = __builtin_amdgcn_mfma_f32_16x16x32_bf16(af[m], vb[cc], ST[m][cc], 0, 0, 0); }
#pragma unroll
            for (int m = 0; m < 2; ++m)
#pragma unroll
                for (int cc = 0; cc < 4; ++cc) { v2u o; o.x = pk2(ST[m][cc][0], ST[m][cc][1]); o.y = pk2(ST[m][cc][2], ST[m][cc][3]);
                    *(LAS v2u*)(lds + ST_OFF + (16 * cc + fr) * STP + (32 * w + 16 * m + 4 * fq) * 2) = o; }
            __syncthreads();
        }
    }
}
__device__ __forceinline__ void ret_finish(Frame& F) {
    const bf16* RQ = (const bf16*)(F.ws + A_RQ); const bf16* OFp = (const bf16*)(F.ws + A_OF); const bf16* OBp = (const bf16*)(F.ws + A_OB); bf16* FIN = (bf16*)(F.ws + A_FIN);
    const int gw = F.vcu * NWAVES + F.wave, NGW = F.G * NWAVES, lane = F.lane;
    for (int it = gw; it < NT * 4; it += NGW) {
        const int r = it >> 2, h = it & 3; const size_t o = (size_t)r * 2048 + h * 512 + lane * 8;
        const v4u a = *(const v4u*)(OFp + o), c = *(const v4u*)(OBp + o), gg = *(const v4u*)(RQ + (size_t)r * 6144 + 4096 + h * 512 + lane * 8);
        float x[8] = {bflo(a.x) + bflo(c.x), bfhi(a.x) + bfhi(c.x), bflo(a.y) + bflo(c.y), bfhi(a.y) + bfhi(c.y), bflo(a.z) + bflo(c.z), bfhi(a.z) + bfhi(c.z), bflo(a.w) + bflo(c.w), bfhi(a.w) + bfhi(c.w)};
        float ss = 0.f;
#pragma unroll
        for (int k = 0; k < 8; ++k) ss += x[k] * x[k];
        const float rinv = 1.0f / sqrtf(wave_sum(ss) * (1.0f / 512.0f) + RMS_EPS);
        const float gf[8] = {bflo(gg.x), bfhi(gg.x), bflo(gg.y), bfhi(gg.y), bflo(gg.z), bfhi(gg.z), bflo(gg.w), bfhi(gg.w)};
        float y[8];
#pragma unroll
        for (int k = 0; k < 8; ++k) y[k] = pg8::silu_f(gf[k]) * x[k] * rinv;
        v4u ov; ov.x = pk2(y[0], y[1]); ov.y = pk2(y[2], y[3]); ov.z = pk2(y[4], y[5]); ov.w = pk2(y[6], y[7]);
        *(v4u*)(FIN + o) = ov;
    }
}
constexpr int NPHASE = 2 + 12 * NLAYER;
__host__ __device__ constexpr int layer_kind(int L) { return L == 1 ? 1 : (L == 2 ? 2 : 0); }
__host__ __device__ constexpr bool layer_moe(int L) { return (L & 1) != 0; }
__host__ __device__ constexpr bool phase_exists(int p) {
    if (p < 2) return true;
    const int L = (p - 2) / 12, s = (p - 2) % 12, k = layer_kind(L);
    if (L >= NLAYER) return false;
    switch (s) { case 0: return true; case 1: return k != 1; case 2: return true; case 3: return k == 2; case 4: return true; case 5: return true;
                 case 6: return layer_moe(L); case 7: return true; case 8: return true; case 9: return true; default: return false; }
}
__host__ __device__ constexpr int last_phase() { return 2 + 12 * (NLAYER - 1) + 9; }

#define IN(k) (lo <= (k) && (k) < hi)
#define SEAM(k) do { if (multi && (k) + 1 < hi && (k) != last_phase()) xcd_barrier(bar); } while (0)
template <int L>
__device__ __forceinline__ void layer_phases(Frame& F, const Args& args, const int lo, const int hi, const bool multi, const XcdBarrier& bar) {
    unsigned char* ws = args.ws;

        constexpr int pb = 2 + 12 * L, kind = layer_kind(L); constexpr bool moe = layer_moe(L);
        constexpr int ib = L == 0 ? 4 : (L == 1 ? 16 : (L == 2 ? 33 : 44));
        const float* ada0 = (const float*)(ws + WS_ADA) + (size_t)L * 5 * 6144;
        if (IN(pb + 0)) {
            if constexpr (kind == 1) {
                pg8::Gemm g{(const pg8::bf16_t*)(ws + WS_H), (const pg8::bf16_t*)(ws + W_L1_IN), NT, 4096, 1024, nullptr, 0};
                pg8::StaticOrder S; S.init(NT, 4096, F.G, (int)blockIdx.x);
                pg8::EpiGelu E{(pg8::bf16_t*)(ws + A_Z), 4096, args.in[23], (float*)(ws + WS_PS), 8};
                pg8::gemm_phase<pg8::EpiGelu, pg8::StaticOrder, true, true>(F.lds, g, S, E);
            } else {
                constexpr int N = kind == 0 ? 1536 : 6144;
                constexpr size_t wo = kind == 2 ? W_L2_IN : (L == 0 ? W_L0_QKV : W_L3_QKV);
                pg8::Gemm g{(const pg8::bf16_t*)(ws + WS_H), (const pg8::bf16_t*)(ws + wo), NT, N, 1024, nullptr, 0};
                pg8::StaticOrder S; S.init(NT, N, F.G, (int)blockIdx.x);
                pg8::EpiStore E{(pg8::bf16_t*)(ws + WS_ACT), N};
                pg8::gemm_phase<pg8::EpiStore, pg8::StaticOrder, true, true>(F.lds, g, S, E);
            }
            SEAM(pb + 0);
        }
        if constexpr (kind != 1) if (IN(pb + 1)) {
            if constexpr (kind == 0) attn_normrope(F, args.in[ib + 7], args.in[ib + 8]); else ret_rope(F);
            SEAM(pb + 1);
        }
        if (IN(pb + 2)) {
            if constexpr (kind == 0) attn_units(F, (char*)F.lds);
            else if constexpr (kind == 1) cmlp_mix(F, args.in[24], args.in[25], args.in[26], args.in[27]);
            else ret_scan(F, args.in[40]);
            SEAM(pb + 2);
        }
        if constexpr (kind == 2) if (IN(pb + 3)) { ret_finish(F); SEAM(pb + 3); }
        if (IN(pb + 4)) {
            constexpr int K = kind == 0 ? 1024 : 2048;
            constexpr size_t ao = kind == 0 ? A_O : (kind == 1 ? A_UV : A_FIN);
            constexpr size_t wo = kind == 1 ? W_L1_OUT : (kind == 2 ? W_L2_WO : (L == 0 ? W_L0_WO : W_L3_WO));
            pg8::Gemm g{(const pg8::bf16_t*)(ws + ao), (const pg8::bf16_t*)(ws + wo), NT, 1024, K, nullptr, 0};
            pg8::StaticOrder S; S.init(NT, 1024, F.G, (int)blockIdx.x);
            pg8::EpiRes E{(float*)(ws + WS_X), ada0 + 2 * 1024, kind == 1 ? args.in[29] : nullptr, DN_ALPHA};
            pg8::gemm_phase<pg8::EpiRes, pg8::StaticOrder, true, true>(F.lds, g, S, E);
            SEAM(pb + 4);
        }
        if (IN(pb + 5)) {
            RowP P{1, L, moe ? 1 : 0, args.in[ib + 2], args.in[ib + 3], moe ? (L == 1 ? args.in[30] : args.in[54]) : nullptr};
            row_phase(F, args, P); SEAM(pb + 5);
        }
        if constexpr (moe) if (IN(pb + 6)) { moe_scatter(F, L); SEAM(pb + 6); }
        if (IN(pb + 7)) {
            if constexpr (moe) {
                moe_layout(F, L);
                const LAS unsigned* T = (const LAS unsigned*)(F.lds + LDS_MOE_OFF); const int M = (int)T[0] * 256;
                pg8::Gemm g{(const pg8::bf16_t*)(ws + A_HP), (const pg8::bf16_t*)(ws + WM_GU), M, 7168, 1024, (const LAS unsigned char*)(T + 20), (size_t)7168 * 1024 * 2};
                pg8::StaticOrder S; S.init(M, 7168, F.G, (int)blockIdx.x);
                pg8::EpiSwiglu E{(pg8::bf16_t*)(ws + A_HM), FFN};
                pg8::gemm_phase<pg8::EpiSwiglu, pg8::StaticOrder, true, true>(F.lds, g, S, E);
            } else {
                pg8::Gemm g{(const pg8::bf16_t*)(ws + WS_H), (const pg8::bf16_t*)(ws + (L == 0 ? W_L0_GU : W_L2_GU)), NT, 7168, 1024, nullptr, 0};
                pg8::StaticOrder S; S.init(NT, 7168, F.G, (int)blockIdx.x);
                pg8::EpiSwiglu E{(pg8::bf16_t*)(ws + A_HID), FFN};
                pg8::gemm_phase<pg8::EpiSwiglu, pg8::StaticOrder, true, true>(F.lds, g, S, E);
            }
            SEAM(pb + 7);
        }
        if (IN(pb + 8)) {
            if constexpr (moe) {
                moe_layout(F, L);
                const LAS unsigned* T = (const LAS unsigned*)(F.lds + LDS_MOE_OFF); const int M = (int)T[0] * 256;
                pg8::Gemm g{(const pg8::bf16_t*)(ws + A_HM), (const pg8::bf16_t*)(ws + WM_DN), M, 1024, FFN, (const LAS unsigned char*)(T + 20), (size_t)1024 * FFN * 2};
                pg8::StaticOrder S; S.init(M, 1024, F.G, (int)blockIdx.x);
                pg8::EpiStore E{(pg8::bf16_t*)(ws + A_OM), 1024};
                pg8::gemm_phase<pg8::EpiStore, pg8::StaticOrder, true, true>(F.lds, g, S, E);
            } else {
                pg8::Gemm g{(const pg8::bf16_t*)(ws + A_HID), (const pg8::bf16_t*)(ws + (L == 0 ? W_L0_DN : W_L2_DN)), NT, 1024, FFN, nullptr, 0};
                pg8::StaticOrder S; S.init(NT, 1024, F.G, (int)blockIdx.x);
                pg8::EpiRes E{(float*)(ws + WS_X), ada0 + 5 * 1024, nullptr, DN_ALPHA};
                pg8::gemm_phase<pg8::EpiRes, pg8::StaticOrder, true, true>(F.lds, g, S, E);
            }
            SEAM(pb + 8);
        }
        if (IN(pb + 9)) {
            RowP P{2, L, moe ? 1 : 0, args.in[ib + 4], args.in[ib + 5], nullptr};
            row_phase(F, args, P);
            if constexpr (L == 1) convert_set_b(F, args);
            SEAM(pb + 9);
        }
    }
#undef IN
#undef SEAM

__global__ void __launch_bounds__(NWAVES * 64, 2) mega_fwd(Args args) {
    extern __shared__ __attribute__((aligned(16))) unsigned char lds[];
    Frame F;
    F.lds = (LAS unsigned char*)lds; F.ws = args.ws; F.ctl = (gu32*)(args.ws + WS_CTL);
    F.tid = threadIdx.x; F.lane = F.tid & 63; F.wave = __builtin_amdgcn_readfirstlane(F.tid >> 6);
    F.G = gridDim.x; { const int bx = blockIdx.x; F.vcu = (F.G % 8 == 0) ? (bx % 8) * (F.G / 8) + bx / 8 : bx; }
    volatile LAS unsigned* MISC = (volatile LAS unsigned*)(F.lds + MISC_OFF);
    if (F.tid < 16) MISC[F.tid] = 0u;
    __syncthreads();
    const int lo = args.ph_lo, hi = args.ph_hi;
    const bool multi = (hi - lo) > 1;
    XcdBarrier bar; bar.bar = (unsigned*)(F.ctl + CW_BAR); bar.x = 0; bar.st = nullptr;
    if (multi) bar = xcd_barrier_post((unsigned*)(F.ctl + CW_BAR), MISC);
#define IN(k) (lo <= (k) && (k) < hi)
#define SEAM(k) do { if (multi && (k) + 1 < hi && (k) != last_phase()) xcd_barrier(bar); } while (0)
    unsigned char* ws = args.ws;

    if (IN(0)) { ada_phase(F, args); convert_set_a(F, args); SEAM(0); }
    if (IN(1)) { RowP P{0, 0, 0, nullptr, nullptr, nullptr}; row_phase(F, args, P); SEAM(1); }

    layer_phases<0>(F, args, lo, hi, multi, bar);
    layer_phases<1>(F, args, lo, hi, multi, bar);
    layer_phases<2>(F, args, lo, hi, multi, bar);
    layer_phases<3>(F, args, lo, hi, multi, bar);
#undef IN
#undef SEAM
}

extern "C" void kernel_launch(void* const* d_in, const int* in_sizes, int n_in, void* d_out, int out_size, void* d_ws, size_t ws_size, hipStream_t stream) {
    static int grid = 0;
    if (grid == 0) {
        if (n_in != 57 || out_size != NBATCH * SEQ * DM || ws_size < WS_END) { fprintf(stderr, "kernel_launch: unexpected shapes: n_in %d out %d ws %zu (need %zu)\n", n_in, out_size, ws_size, (size_t)WS_END); grid = -1; return; }
        int dev = 0, cus = 0;
        if (hipGetDevice(&dev) != hipSuccess || hipDeviceGetAttribute(&cus, hipDeviceAttributeMultiprocessorCount, dev) != hipSuccess) { grid = -1; return; }
        if (hipFuncSetAttribute((const void*)mega_fwd, hipFuncAttributeMaxDynamicSharedMemorySize, LDS_BYTES) != hipSuccess) { fprintf(stderr, "kernel_launch: hipFuncSetAttribute failed\n"); grid = -1; return; }
        int per_cu = 0;
        if (hipOccupancyMaxActiveBlocksPerMultiprocessor(&per_cu, (const void*)mega_fwd, NWAVES * 64, LDS_BYTES) != hipSuccess || per_cu < 1) fprintf(stderr, "kernel_launch: occupancy query says %d\n", per_cu);
        (void)hipGetLastError();
        grid = cus;
    }
    if (grid < 0) return;
    if (hipMemsetAsync((char*)d_ws + WS_CTL, 0, CTL_ZERO_BYTES, stream) != hipSuccess) return;
    Args a{};
    for (int i = 0; i < 57; ++i) a.in[i] = (const float*)d_in[i];
    a.out = (float*)d_out; a.ws = (unsigned char*)d_ws;
#if SINGLE_LAUNCH
    a.ph_lo = 0; a.ph_hi = NPHASE;
    hipLaunchKernelGGL(mega_fwd, dim3(grid), dim3(NWAVES * 64), LDS_BYTES, stream, a);
#else
    for (int p = 0; p < NPHASE; ++p) {
        if (!phase_exists(p)) continue;
        a.ph_lo = p; a.ph_hi = p + 1;
        hipLaunchKernelGGL(mega_fwd, dim3(grid), dim3(NWAVES * 64), LDS_BYTES, stream, a);
    }
#endif
    const hipError_t le = hipPeekAtLastError();
    if (le != hipSuccess) fprintf(stderr, "kernel_launch: launch failed: %s\n", hipGetErrorName(le));
}
```
